# Optimizing an MI355X kernel written in HIP

```python
import math
import numpy as np
import jax
import jax.numpy as jnp
from jax import lax

D_MODEL = 1024
BATCH = 2
SEQ = 16384
DEPTH = 4

HEAD_DIM = 64
NSA_HEADS = 4
NSA_KV_HEADS = 1
CMP_BLOCK = 32
CMP_STRIDE = 16
SEL_BLOCK = 64
SEL_TOPK = 16
NSA_WINDOW = 512
DIL_PATTERNS = ((128, 1), (512, 4), (2048, 16))
DIL_HEADS_PER_GROUP = 2
DIL_HEADS = DIL_HEADS_PER_GROUP * len(DIL_PATTERNS)
SWA_HEADS = 6
SWA_KV_HEADS = 2
SWA_WINDOW = 128
BLOCK_Q = 128
D_FF = 2816
CONV_WIDTH = 3
ROPE_THETA = 10000.0
RMS_EPS = 1e-6
NEG = -1e30
TINY = 1e-30
FORCE = 1e4
COL_SIZES = ((NSA_HEADS * HEAD_DIM,) + (NSA_KV_HEADS * HEAD_DIM,) * 6 + (3 * NSA_HEADS,)
             + (DIL_HEADS * HEAD_DIM,) * 3
             + (SWA_HEADS * HEAD_DIM, SWA_KV_HEADS * HEAD_DIM, SWA_KV_HEADS * HEAD_DIM))
IN_COLS = sum(COL_SIZES)
MIX_WIDTH = (NSA_HEADS + DIL_HEADS + SWA_HEADS) * HEAD_DIM

kernel_name = 'hybrid_nsa_dilated_swa_convffn_trunk'


def _rmsnorm(x, w):
    xf = x.astype(jnp.float32)
    y = xf * lax.rsqrt(jnp.mean(xf * xf, axis=-1, keepdims=True) + RMS_EPS)
    return (y * w.astype(jnp.float32)).astype(x.dtype)


def _rope_tables(positions, dtype):
    inv = ROPE_THETA ** (-jnp.arange(0, HEAD_DIM, 2, dtype=jnp.float32) / HEAD_DIM)
    ang = positions.astype(jnp.float32)[..., None] * inv
    return (jnp.cos(ang)[:, :, None, :].astype(dtype),
            jnp.sin(ang)[:, :, None, :].astype(dtype))


def _apply_rope(t, cos, sin):
    t1, t2 = jnp.split(t, 2, axis=-1)
    return jnp.concatenate([t1 * cos - t2 * sin, t2 * cos + t1 * sin], axis=-1)


def _masked_softmax(s, mask):
    s = jnp.where(mask, s, NEG)
    m = jnp.max(s, axis=-1, keepdims=True)
    p = jnp.where(mask, jnp.exp(s - m), 0.0)
    return p / jnp.maximum(jnp.sum(p, axis=-1, keepdims=True), TINY)


def _band_blocks(t, n_prev, block):
    B, S = t.shape[:2]
    nb = S // block
    tb = t.reshape((B, nb, block) + t.shape[2:])
    tp = jnp.pad(tb, [(0, 0), (n_prev, 0)] + [(0, 0)] * (tb.ndim - 2))
    return jnp.concatenate([tp[:, i:i + nb] for i in range(n_prev + 1)], axis=2)


def _banded_attention(q, k, v, max_dist, block, sinks=None, return_lse=False):
    B, S, Hk, G, hd = q.shape
    block = math.gcd(block, S)
    nb = S // block
    n_prev = -(-max_dist // block)
    span = (n_prev + 1) * block
    kw = _band_blocks(k, n_prev, block)
    vw = _band_blocks(v, n_prev, block)
    qb = q.reshape(B, nb, block, Hk, G, hd)
    s = jnp.einsum('bnqhgd,bnkhd->bnhgqk', qb, kw).astype(jnp.float32) * (hd ** -0.5)
    dist = jnp.arange(block)[:, None] + n_prev * block - jnp.arange(span)[None, :]
    kpos = jnp.arange(nb)[:, None] * block - n_prev * block + jnp.arange(span)[None, :]
    mask = ((dist >= 0) & (dist <= max_dist))[None] & (kpos >= 0)[:, None, :]
    mask = mask[None, :, None, None]
    s = jnp.where(mask, s, NEG)
    m = jnp.max(s, axis=-1, keepdims=True)
    if sinks is not None:
        sk = sinks.astype(jnp.float32).reshape(1, 1, Hk, G, 1, 1)
        m = jnp.maximum(m, sk)
    p = jnp.where(mask, jnp.exp(s - m), 0.0)
    l = jnp.sum(p, axis=-1, keepdims=True)
    if sinks is not None:
        l = l + jnp.exp(sk - m)
    o = jnp.einsum('bnhgqk,bnkhd->bnqhgd', (p / l).astype(v.dtype), vw).reshape(B, S, Hk, G, hd)
    if not return_lse:
        return o
    lse = (m + jnp.log(l))[..., 0].transpose(0, 1, 4, 2, 3).reshape(B, S, Hk, G)
    return o, lse


def _compress(t, w, pe):
    B, S, Hk, hd = t.shape
    r = CMP_BLOCK // CMP_STRIDE
    n = S // CMP_STRIDE
    ts = t.reshape(B, n, CMP_STRIDE, Hk, hd)
    blocks = jnp.concatenate([ts[:, i:n - r + 1 + i] for i in range(r)], axis=2)
    return jnp.einsum('bnlhd,lde->bnhe', blocks + pe[:, None, :], w)


def _nsa(q, k_c, v_c, k_s, v_s, k_w, v_w, gates, w_ck, w_cv, pe_k, pe_v):
    B, S, Hk, G, hd = q.shape
    kc = _compress(k_c, w_ck, pe_k)
    vc = _compress(v_c, w_cv, pe_v)
    n_cmp = kc.shape[1]
    n_sel = S // SEL_BLOCK
    top = min(SEL_TOPK, n_sel)
    cmp_end = jnp.arange(n_cmp) * CMP_STRIDE + CMP_BLOCK - 1
    ci = jnp.arange(n_cmp)[:, None] * CMP_STRIDE
    sj = jnp.arange(n_sel)[None, :] * SEL_BLOCK
    overlap = ((ci < sj + SEL_BLOCK) & (ci + CMP_BLOCK > sj)).astype(jnp.float32)
    ks_blk = k_s.reshape(B, n_sel, SEL_BLOCK, Hk, hd).transpose(0, 3, 1, 2, 4)
    vs_blk = v_s.reshape(B, n_sel, SEL_BLOCK, Hk, hd).transpose(0, 3, 1, 2, 4)
    nb = S // BLOCK_Q
    q_blocks = q.reshape(B, nb, BLOCK_Q, Hk, G, hd).transpose(1, 0, 2, 3, 4, 5)
    scale = hd ** -0.5
    gather = jax.vmap(jax.vmap(lambda blk, ids: blk[ids]))

    def per_block(args):
        qb, b = args
        t = b * BLOCK_Q + jnp.arange(BLOCK_Q)
        s = jnp.einsum('bqhgd,bnhd->bhgqn', qb, kc).astype(jnp.float32) * scale
        p = _masked_softmax(s, cmp_end[None, :] <= t[:, None])
        o_cmp = jnp.einsum('bhgqn,bnhd->bqhgd', p.astype(vc.dtype), vc)
        imp = jnp.einsum('bhgqn,nj->bhqj', p, overlap)
        blk = jnp.arange(n_sel)[None, :]
        cur = (t // SEL_BLOCK)[:, None]
        forced = (blk == 0) | (blk == cur) | (blk == cur - 1)
        imp = jnp.where(forced, FORCE, imp)
        imp = jnp.where(blk <= cur, imp, NEG)
        val, idx = lax.top_k(imp, top)
        ks = gather(ks_blk, idx)
        vs = gather(vs_blk, idx)
        s2 = jnp.einsum('bqhgd,bhqkld->bhgqkl', qb, ks).astype(jnp.float32) * scale
        kpos = idx[..., None] * SEL_BLOCK + jnp.arange(SEL_BLOCK)
        m2 = (val[..., None] > NEG / 2) & (kpos <= t[:, None, None])
        n_k = top * SEL_BLOCK
        p2 = _masked_softmax(s2.reshape(B, Hk, G, BLOCK_Q, n_k), m2.reshape(B, Hk, 1, BLOCK_Q, n_k))
        o_sel = jnp.einsum('bhgqn,bhqnd->bqhgd', p2.astype(vs.dtype), vs.reshape(B, Hk, BLOCK_Q, n_k, hd))
        return o_cmp, o_sel

    o_cmp, o_sel = lax.map(per_block, (q_blocks, jnp.arange(nb)))
    o_cmp = o_cmp.transpose(1, 0, 2, 3, 4, 5).reshape(B, S, Hk, G, hd)
    o_sel = o_sel.transpose(1, 0, 2, 3, 4, 5).reshape(B, S, Hk, G, hd)
    o_win = _banded_attention(q, k_w, v_w, NSA_WINDOW - 1, BLOCK_Q)
    return gates[..., 0:1] * o_cmp + gates[..., 1:2] * o_sel + gates[..., 2:3] * o_win


def _dilated_group(q, k, v, window, dilation):
    B, S, H, hd = q.shape
    n = S // dilation

    def fold(t):
        return t.reshape(B, n, dilation, H, hd).transpose(0, 2, 1, 3, 4).reshape(B * dilation, n, H, hd)

    o, lse = _banded_attention(fold(q)[:, :, :, None], fold(k), fold(v), window // dilation, BLOCK_Q,
                               return_lse=True)
    o = o[:, :, :, 0].reshape(B, dilation, n, H, hd).transpose(0, 2, 1, 3, 4).reshape(B, S, H, hd)
    lse = lse[..., 0].reshape(B, dilation, n, H).transpose(0, 2, 1, 3).reshape(B, S, H)
    return o, lse


def _token_mixers(h, cos, sin, w_in, w_out, w_ck, w_cv, pe_k, pe_v, sinks):
    B, S, _ = h.shape
    proj = h @ w_in
    split_at = np.cumsum(COL_SIZES)[:-1].tolist()
    (a_q, a_kc, a_vc, a_ks, a_vs, a_kw, a_vw, a_g,
     b_q, b_k, b_v, c_q, c_k, c_v) = jnp.split(proj, split_at, axis=-1)

    def heads(t, n):
        return t.reshape(B, S, n, HEAD_DIM)

    def rope(t):
        return _apply_rope(t, cos, sin)

    ga = NSA_HEADS // NSA_KV_HEADS
    qa = rope(heads(a_q, NSA_HEADS)).reshape(B, S, NSA_KV_HEADS, ga, HEAD_DIM)
    gates = jax.nn.sigmoid(a_g).reshape(B, S, NSA_KV_HEADS, ga, 3)
    out_a = _nsa(qa,
                 rope(heads(a_kc, NSA_KV_HEADS)), heads(a_vc, NSA_KV_HEADS),
                 rope(heads(a_ks, NSA_KV_HEADS)), heads(a_vs, NSA_KV_HEADS),
                 rope(heads(a_kw, NSA_KV_HEADS)), heads(a_vw, NSA_KV_HEADS),
                 gates, w_ck, w_cv, pe_k, pe_v).reshape(B, S, NSA_HEADS * HEAD_DIM)

    qb, kb, vb = rope(heads(b_q, DIL_HEADS)), rope(heads(b_k, DIL_HEADS)), heads(b_v, DIL_HEADS)
    outs, lses = [], []
    for g, (win, dil) in enumerate(DIL_PATTERNS):
        sl = slice(g * DIL_HEADS_PER_GROUP, (g + 1) * DIL_HEADS_PER_GROUP)
        o, lse = _dilated_group(qb[:, :, sl], kb[:, :, sl], vb[:, :, sl], win, dil)
        outs.append(o)
        lses.append(lse)
    alpha = jax.nn.softmax(jnp.stack(lses, axis=0), axis=0)
    out_b = jnp.concatenate([o * alpha[g][..., None].astype(o.dtype) for g, o in enumerate(outs)],
                            axis=2).reshape(B, S, DIL_HEADS * HEAD_DIM)

    gc = SWA_HEADS // SWA_KV_HEADS
    qc = rope(heads(c_q, SWA_HEADS)).reshape(B, S, SWA_KV_HEADS, gc, HEAD_DIM)
    out_c = _banded_attention(qc, rope(heads(c_k, SWA_KV_HEADS)), heads(c_v, SWA_KV_HEADS),
                              SWA_WINDOW - 1, BLOCK_Q,
                              sinks=sinks.reshape(SWA_KV_HEADS, gc)).reshape(B, S, SWA_HEADS * HEAD_DIM)

    return jnp.concatenate([out_a, out_b, out_c], axis=-1) @ w_out


def _conv_ffn(h, w_gate, w_up, conv_w, conv_b, w_down):
    S = h.shape[1]
    g = h @ w_gate
    gp = jnp.pad(g, ((0, 0), (CONV_WIDTH - 1, 0), (0, 0)))
    acc = gp[:, 0:S] * conv_w[0]
    for i in range(1, CONV_WIDTH):
        acc = acc + gp[:, i:i + S] * conv_w[i]
    return (jax.nn.gelu(acc + conv_b, approximate=True) * (h @ w_up)) @ w_down


def setup_inputs(seed: int = 0) -> dict:
    key = jax.random.key(seed)
    ks = jax.random.split(key, 20)
    f32 = jnp.float32

    def nrm(k, shape, scale):
        return jax.random.normal(k, shape, f32) * scale

    x = nrm(ks[0], (BATCH, SEQ, D_MODEL), 1.0)
    c = nrm(ks[1], (BATCH, D_MODEL), 1.0)
    offset = jax.random.randint(ks[2], (BATCH, 1), 0, 4096, dtype=jnp.int32)
    positions = jnp.arange(SEQ, dtype=jnp.int32)[None, :] + offset
    w_in = nrm(ks[3], (DEPTH, D_MODEL, IN_COLS), D_MODEL ** -0.5)
    w_out = nrm(ks[4], (DEPTH, MIX_WIDTH, D_MODEL), MIX_WIDTH ** -0.5)
    w_ada = nrm(ks[5], (DEPTH, D_MODEL, 6 * D_MODEL), 0.5 * D_MODEL ** -0.5)
    b_ada = nrm(ks[6], (DEPTH, 6 * D_MODEL), 0.01)
    norm_w = 1.0 + nrm(ks[7], (DEPTH, 4, D_MODEL), 0.05)
    cmp_w_k = nrm(ks[8], (DEPTH, CMP_BLOCK, HEAD_DIM, HEAD_DIM), (CMP_BLOCK * HEAD_DIM) ** -0.5)
    cmp_w_v = nrm(ks[9], (DEPTH, CMP_BLOCK, HEAD_DIM, HEAD_DIM), (CMP_BLOCK * HEAD_DIM) ** -0.5)
    cmp_pe_k = nrm(ks[10], (DEPTH, CMP_BLOCK, HEAD_DIM), 0.5)
    cmp_pe_v = nrm(ks[11], (DEPTH, CMP_BLOCK, HEAD_DIM), 0.5)
    sinks = nrm(ks[12], (DEPTH, SWA_HEADS), 1.0)
    w_gate = nrm(ks[13], (DEPTH, D_MODEL, D_FF), D_MODEL ** -0.5)
    w_up = nrm(ks[14], (DEPTH, D_MODEL, D_FF), D_MODEL ** -0.5)
    conv_w = nrm(ks[15], (DEPTH, CONV_WIDTH, D_FF), CONV_WIDTH ** -0.5)
    conv_b = nrm(ks[16], (DEPTH, D_FF), 0.01)
    w_down = nrm(ks[17], (DEPTH, D_FF, D_MODEL), D_FF ** -0.5)
    return {'x': x, 'c': c, 'positions': positions, 'w_in': w_in, 'w_out': w_out,
            'w_ada': w_ada, 'b_ada': b_ada, 'norm_w': norm_w,
            'cmp_w_k': cmp_w_k, 'cmp_w_v': cmp_w_v, 'cmp_pe_k': cmp_pe_k, 'cmp_pe_v': cmp_pe_v,
            'sinks': sinks, 'w_gate': w_gate, 'w_up': w_up, 'conv_w': conv_w, 'conv_b': conv_b,
            'w_down': w_down}


def reference(x, c, positions, w_in, w_out, w_ada, b_ada, norm_w, cmp_w_k, cmp_w_v, cmp_pe_k, cmp_pe_v,
              sinks, w_gate, w_up, conv_w, conv_b, w_down):
    cos, sin = _rope_tables(positions, x.dtype)
    cond = jax.nn.silu(c)
    for layer in range(DEPTH):
        ada = cond @ w_ada[layer] + b_ada[layer]
        sh1, sc1, g1, sh2, sc2, g2 = [a[:, None, :] for a in jnp.split(ada, 6, axis=-1)]
        h = _rmsnorm(x, norm_w[layer, 0]) * (1 + sc1) + sh1
        h = _token_mixers(h, cos, sin, w_in[layer], w_out[layer], cmp_w_k[layer], cmp_w_v[layer],
                          cmp_pe_k[layer], cmp_pe_v[layer], sinks[layer])
        x = x + g1 * _rmsnorm(h, norm_w[layer, 1])
        h = _rmsnorm(x, norm_w[layer, 2]) * (1 + sc2) + sh2
        h = _conv_ffn(h, w_gate[layer], w_up[layer], conv_w[layer], conv_b[layer], w_down[layer])
        x = x + g2 * _rmsnorm(h, norm_w[layer, 3])
    return x
```

```cpp
#include <hip/hip_runtime.h>
#include <hip/hip_cooperative_groups.h>
#include <cstdio>
#include <cstdint>
#include <cmath>
namespace cg = cooperative_groups;

typedef _Float16 half_t;
typedef _Float16 half8 __attribute__((ext_vector_type(8)));
typedef _Float16 half4 __attribute__((ext_vector_type(4)));
typedef _Float16 half2v __attribute__((ext_vector_type(2)));
typedef float f32x4 __attribute__((ext_vector_type(4)));
typedef unsigned u32x4 __attribute__((ext_vector_type(4)));
typedef unsigned u32x2 __attribute__((ext_vector_type(2)));

constexpr int D = 1024, NBATCH = 2, S = 16384, M = NBATCH * S, DEPTH = 4, DFF = 2816;
constexpr int NPROJ = 2560, NIN = 2444, NGU = 2 * DFF;
constexpr float RMS_EPS = 1e-6f;
constexpr float QSCALE = 0.125f * 1.4426950408889634f;
constexpr float LOG2E = 1.4426950408889634f;
constexpr int NWAVES = 8, NTHREADS = 512;

constexpr size_t MiB = 1u << 20;
constexpr size_t WS_WT_IN = 0;
constexpr size_t WS_WT_OUT = 20 * MiB;
constexpr size_t WS_WT_DN = 28 * MiB;
constexpr size_t WS_WT_GU = 50 * MiB;
constexpr size_t WS_COS = 61 * MiB;
constexpr size_t WS_SIN = 65 * MiB;
constexpr size_t WS_ADA = 69 * MiB;
constexpr size_t WS_KC = 70 * MiB;
constexpr size_t WS_VCT = 70 * MiB + 512 * 1024;
constexpr size_t WS_LSE = 71 * MiB;
constexpr size_t WS_HX = 72 * MiB;
constexpr size_t WS_BIG = 136 * MiB;
constexpr size_t WS_PROJ = WS_BIG;
constexpr size_t WS_MIX = WS_BIG + 160 * MiB;
constexpr size_t WS_VT = WS_BIG + 224 * MiB;
constexpr size_t WS_KF = WS_BIG + 264 * MiB;
constexpr size_t WS_ACT = WS_BIG;
constexpr size_t WS_GB = WS_BIG + 176 * MiB;
constexpr size_t WS_UB = WS_BIG + 182 * MiB;
constexpr size_t WS_X16 = 440 * MiB;
constexpr size_t WS_CW = 504 * MiB;
constexpr size_t WS_CB = WS_ADA + 256 * 1024;
constexpr size_t WS_BAR = 506 * MiB;
constexpr size_t WS_KS8 = 507 * MiB;
constexpr size_t WS_VS8 = 509 * MiB;
constexpr size_t WS_END = 511 * MiB;

constexpr int LDS_BYTES = 151552;

namespace pg8 {
#define PG8_LAS __attribute__((address_space(3)))
constexpr int BM = 256, BK = 64, HALF = 128, HTB = HALF * BK * 2, STAGE_BYTES = 8 * HTB, NXCD = 8, WGM = 8;

__host__ __device__ __forceinline__ int lds_byte(int r, int c) { const int st = (r >> 4) * 2 + (c >> 5), rr = r & 15, cc = c & 31, ob = rr * 64 + cc * 2; return st * 1024 + (ob ^ (((ob >> 9) & 1) << 5)); }
__host__ __device__ __forceinline__ void stage_rc(int b, int& R, int& C) { const int st = b / 1024, sb = b % 1024, swz = sb ^ (((sb >> 9) & 1) << 5); R = (st >> 1) * 16 + swz / 64; C = (st & 1) * 32 + (swz % 64) / 2; }
__host__ __device__ __forceinline__ int perm32(int rho) { const int n = rho >> 4, i = rho & 15; return 8 * (i >> 2) + 4 * n + (i & 3); }

struct Unit { int pm, pn; };
struct Gemm { const half_t* A; const half_t* Bt; int M, N, K, lda; };

struct StaticOrder {
    int nM, nN, nwg, G, c;
    __host__ __device__ void init(int M_, int N_, int G_, int c_) { nM = M_ / BM; nN = N_ / BM; nwg = nM * nN; G = G_; c = c_; }
    __host__ __device__ bool next(int i, Unit& u) const {
        const long L = (long)i * G + c; if (L >= nwg) return false;
        int wgid = (int)L; { const int q = nwg / NXCD, r = nwg % NXCD, xcd = wgid % NXCD, off = wgid / NXCD; wgid = (xcd < r ? xcd * (q + 1) : r * (q + 1) + (xcd - r) * q) + off; }
        const int nig = WGM * nN, gid = wgid / nig, fm = gid * WGM, gsz = (nM - fm) < WGM ? (nM - fm) : WGM;
        u.pm = fm + ((wgid % nig) % gsz); u.pn = (wgid % nig) / gsz; return true;
    }
};

__device__ __forceinline__ unsigned pkh(float lo, float hi) { half2v v = {(half_t)lo, (half_t)hi}; return __builtin_bit_cast(unsigned, v); }

struct EpiF16 {
    static constexpr bool PERM = true;
    half_t* O; int ldc;
    __device__ __forceinline__ void operator()(const f32x4 (&acc)[2][2][4][2], const Unit& u, int wr, int wc, int fr, int fq, PG8_LAS unsigned char*) const {
        const int row0 = u.pm * BM + wr * 64 + fr; const int col0 = u.pn * BM + wc * 32 + 8 * fq;
#pragma unroll
        for (int ai = 0; ai < 2; ++ai)
#pragma unroll
            for (int m = 0; m < 4; ++m) { half_t* rowp = O + (size_t)(row0 + ai * HALF + m * 16) * ldc + col0;
#pragma unroll
                for (int bj = 0; bj < 2; ++bj) { const f32x4 v0 = acc[ai][bj][m][0], v1 = acc[ai][bj][m][1];
                    u32x4 w; w.x = pkh(v0[0], v0[1]); w.y = pkh(v0[2], v0[3]); w.z = pkh(v1[0], v1[1]); w.w = pkh(v1[2], v1[3]);
                    *(u32x4*)(rowp + bj * HALF) = w; } }
    }
};

struct EpiProj {
    static constexpr bool PERM = true;
    half_t* P; const float* cosT; const float* sinT; half_t* vt; half_t* kf; unsigned char* ks8; unsigned char* vs8;
    __device__ __forceinline__ void operator()(const f32x4 (&acc)[2][2][4][2], const Unit& u, int wr, int wc, int fr, int fq, PG8_LAS unsigned char* lds) const {
        const int row0 = u.pm * BM + wr * 64 + fr; const int gsub = wc & 1;
        bool isq[2], isk[2], isg[2]; int vi[2], ki[2], col0[2];
#pragma unroll
        for (int bj = 0; bj < 2; ++bj) {
            const int slot = u.pn * 4 + bj * 2 + (wc >> 1);
            isq[bj] = (slot < 4) || (slot >= 10 && slot < 16) || (slot >= 28 && slot < 34);
            isk[bj] = slot == 4 || slot == 6 || slot == 8 || (slot >= 16 && slot < 22) || slot == 34 || slot == 35;
            vi[bj] = -1;
            if (slot == 7) vi[bj] = 0; else if (slot == 9) vi[bj] = 1; else if (slot >= 22 && slot < 28) vi[bj] = 2 + (slot - 22); else if (slot == 36 || slot == 37) vi[bj] = 8 + (slot - 36);
            ki[bj] = -1;
            if (slot == 6) ki[bj] = 0; else if (slot == 8) ki[bj] = 1; else if (slot >= 16 && slot < 22) ki[bj] = 2 + (slot - 16); else if (slot == 34 || slot == 35) ki[bj] = 8 + (slot - 34);
            isg[bj] = slot == 38;
            col0[bj] = slot * 64 + gsub * 32 + 8 * fq;
        }
        const bool anyrope = isq[0] || isk[0] || isq[1] || isk[1];
#pragma unroll
        for (int ai = 0; ai < 2; ++ai)
#pragma unroll
            for (int m = 0; m < 4; ++m) {
                const int row = row0 + ai * HALF + m * 16;
                f32x4 cs = {1.f, 1.f, 1.f, 1.f}, sn = {0.f, 0.f, 0.f, 0.f};
                if (anyrope) { cs = *(const f32x4*)(cosT + (size_t)row * 32 + 16 * gsub + 4 * fq); sn = *(const f32x4*)(sinT + (size_t)row * 32 + 16 * gsub + 4 * fq); }
#pragma unroll
                for (int bj = 0; bj < 2; ++bj) {
                    f32x4 v0 = acc[ai][bj][m][0], v1 = acc[ai][bj][m][1];
                    if (isq[bj] || isk[bj]) {
                        const f32x4 o0 = v0 * cs - v1 * sn, o1 = v1 * cs + v0 * sn;
                        v0 = o0; v1 = o1;
                        if (isq[bj]) { v0 = v0 * QSCALE; v1 = v1 * QSCALE; }
                    } else if (isg[bj]) {
#pragma unroll
                        for (int j = 0; j < 4; ++j) { v0[j] = 1.f / (1.f + __expf(-v0[j])); v1[j] = 1.f / (1.f + __expf(-v1[j])); }
                    }
                    u32x4 w; w.x = pkh(v0[0], v0[1]); w.y = pkh(v0[2], v0[3]); w.z = pkh(v1[0], v1[1]); w.w = pkh(v1[2], v1[3]);
                    if (vi[bj] < 0 && ki[bj] < 0) *(u32x4*)(P + (size_t)row * NPROJ + col0[bj]) = w;
                    else {
                        const int b = row >> 14, tl = row & (S - 1);
                        const int xi = vi[bj] >= 0 ? vi[bj] : ki[bj];
                        int pos = tl;
                        if (xi >= 2 && xi < 8) { const int sh = 2 * ((xi - 2) >> 1); pos = ((tl & ((1 << sh) - 1)) << (14 - sh)) + (tl >> sh); }
                        const size_t blk = ((size_t)(xi * 2 + b) * (S / 32) + (pos >> 5)) * 2048;
                        if (ki[bj] == 0) {
                            u32x2 w8; int p0 = __builtin_amdgcn_cvt_pk_fp8_f32(v0[0], v0[1], 0, false); p0 = __builtin_amdgcn_cvt_pk_fp8_f32(v0[2], v0[3], p0, true);
                            int p1 = __builtin_amdgcn_cvt_pk_fp8_f32(v1[0], v1[1], 0, false); p1 = __builtin_amdgcn_cvt_pk_fp8_f32(v1[2], v1[3], p1, true);
                            w8.x = (unsigned)p0; w8.y = (unsigned)p1;
                            *(u32x2*)(ks8 + ((size_t)b * (S / 32) + (pos >> 5)) * 2048 + ((((pos >> 4) & 1) * 2 + gsub) * 64 + (pos & 15) * 4 + fq) * 8) = w8;
                        } else if (ki[bj] >= 0) {
                            *(u32x4*)(kf + blk + ((((pos >> 4) & 1) * 2 + gsub) * 64 + (pos & 15) * 4 + fq) * 8) = w;
                        } else if (xi == 4 || xi == 5) {
                            half_t* vb = vt + blk + ((gsub * 32 + 8 * fq) * 4 + ((pos & 15) >> 2)) * 8 + (pos & 3) + 4 * ((pos >> 4) & 1);
#pragma unroll
                            for (int j = 0; j < 4; ++j) { vb[j * 32] = (half_t)v0[j]; vb[(4 + j) * 32] = (half_t)v1[j]; }
                        }
                    }
                }
            }
#pragma unroll
        for (int bj = 0; bj < 2; ++bj) {
            const int xi = vi[bj];
            if (xi < 0 || xi == 4 || xi == 5) continue;
            const int lane = fq * 16 + fr, wid = wr * 4 + wc;
            if (xi == 6 || xi == 7) {
#pragma unroll
                for (int ai = 0; ai < 2; ++ai) {
                    const int row = row0 + ai * HALF, b = row >> 14, tl = row & (S - 1);
                    const int p = ((tl & 15) << 10) + (tl >> 4);
                    half_t* vb = vt + ((size_t)(xi * 2 + b) * (S / 32) + (p >> 5)) * 2048 + ((gsub * 32 + 8 * fq) * 4 + ((p & 15) >> 2)) * 8 + 4 * ((p >> 4) & 1);
#pragma unroll
                    for (int j = 0; j < 8; ++j) { u32x2 w; w.x = pkh(acc[ai][bj][0][j >> 2][j & 3], acc[ai][bj][1][j >> 2][j & 3]); w.y = pkh(acc[ai][bj][2][j >> 2][j & 3], acc[ai][bj][3][j >> 2][j & 3]); *(u32x2*)(vb + j * 32) = w; }
                }
            } else {
                PG8_LAS half_t* L = (PG8_LAS half_t*)(lds + STAGE_BYTES) + wid * 1024;
                if (xi == 0) {
                    PG8_LAS unsigned char* L8 = (PG8_LAS unsigned char*)L;
#pragma unroll
                    for (int ai = 0; ai < 2; ++ai)
#pragma unroll
                        for (int mp = 0; mp < 2; ++mp) {
#pragma unroll
                            for (int mm = 0; mm < 2; ++mm)
#pragma unroll
                                for (int j = 0; j < 8; ++j) { const float x = acc[ai][bj][2 * mp + mm][j >> 2][j & 3]; L8[((8 * fq + j) * 4 + (fr >> 2)) * 8 + (fr & 3) + 4 * mm] = (unsigned char)(__builtin_amdgcn_cvt_pk_fp8_f32(x, x, 0, false) & 0xff); }
                            asm volatile("s_waitcnt lgkmcnt(0)" ::: "memory"); __builtin_amdgcn_wave_barrier();
                            const int rowb_ = u.pm * BM + ai * HALF + wr * 64 + 32 * mp, b = rowb_ >> 14, tl = rowb_ & (S - 1);
                            unsigned char* vb = vs8 + ((size_t)b * (S / 32) + (tl >> 5)) * 2048 + (size_t)gsub * 1024;
#pragma unroll
                            for (int t = 0; t < 2; ++t) { const int v = lane + 64 * t; const u32x2 w = *(PG8_LAS u32x2*)(L8 + v * 8); *(u32x2*)(vb + v * 8) = w; }
                            asm volatile("s_waitcnt lgkmcnt(0)" ::: "memory"); __builtin_amdgcn_wave_barrier();
                        }
                    continue;
                }
#pragma unroll
                for (int ai = 0; ai < 2; ++ai)
#pragma unroll
                    for (int mp = 0; mp < 2; ++mp) {
#pragma unroll
                        for (int mm = 0; mm < 2; ++mm)
#pragma unroll
                            for (int j = 0; j < 8; ++j) L[((8 * fq + j) * 4 + (fr >> 2)) * 8 + (fr & 3) + 4 * mm] = (half_t)acc[ai][bj][2 * mp + mm][j >> 2][j & 3];
                        asm volatile("s_waitcnt lgkmcnt(0)" ::: "memory"); __builtin_amdgcn_wave_barrier();
                        const int rowb_ = u.pm * BM + ai * HALF + wr * 64 + 32 * mp, b = rowb_ >> 14, tl = rowb_ & (S - 1);
                        half_t* vb = vt + ((size_t)(xi * 2 + b) * (S / 32) + (tl >> 5)) * 2048 + (size_t)gsub * 1024;
#pragma unroll
                        for (int t = 0; t < 2; ++t) { const int v = lane + 64 * t; const u32x4 w = *(PG8_LAS u32x4*)(L + v * 8); *(u32x4*)(vb + v * 8) = w; }
                        asm volatile("s_waitcnt lgkmcnt(0)" ::: "memory"); __builtin_amdgcn_wave_barrier();
                    }
            }
        }
    }
};

__device__ __forceinline__ float gelu_tanh_f(float v) {
    const float z = 0.7978845608028654f * (v + 0.044715f * v * v * v);
    const float t = __builtin_amdgcn_exp2f(z * 2.8853900817779268f);
    return v * (1.f - __builtin_amdgcn_rcpf(t + 1.f));
}
struct EpiAct {
    static constexpr bool PERM = true;
    half_t* act; const float* cw; const float* cb; float* gb; float* ub;
    __device__ __forceinline__ void operator()(const f32x4 (&acc)[2][2][4][2], const Unit& u, int wr, int wc, int fr, int fq, PG8_LAS unsigned char* lds) const {
        PG8_LAS float* halo = (PG8_LAS float*)(lds + STAGE_BYTES);
        const int lane = fq * 16 + fr;
        const int j0 = u.pn * 128 + wc * 32 + 8 * fq;
#pragma unroll
        for (int ai = 0; ai < 2; ++ai)
            if (fr >= 14) { PG8_LAS float* h = halo + ((((ai * 2 + wr) * 4 + wc) * 2 + (fr - 14)) * 32 + fq * 8);
                *(PG8_LAS f32x4*)h = acc[ai][0][3][0]; *(PG8_LAS f32x4*)(h + 4) = acc[ai][0][3][1]; }
        asm volatile("s_waitcnt lgkmcnt(0)" ::: "memory"); __builtin_amdgcn_s_barrier(); asm volatile("" ::: "memory");
        float w0[8], w1[8], w2[8], bb[8];
        { const f32x4 a0 = *(const f32x4*)(cw + j0), a1 = *(const f32x4*)(cw + j0 + 4), b0 = *(const f32x4*)(cw + DFF + j0), b1 = *(const f32x4*)(cw + DFF + j0 + 4);
          const f32x4 c0 = *(const f32x4*)(cw + 2 * DFF + j0), c1 = *(const f32x4*)(cw + 2 * DFF + j0 + 4), d0 = *(const f32x4*)(cb + j0), d1 = *(const f32x4*)(cb + j0 + 4);
#pragma unroll
          for (int j = 0; j < 4; ++j) { w0[j] = a0[j]; w0[4 + j] = a1[j]; w1[j] = b0[j]; w1[4 + j] = b1[j]; w2[j] = c0[j]; w2[4 + j] = c1[j]; bb[j] = d0[j]; bb[4 + j] = d1[j]; } }
#pragma unroll
        for (int ai = 0; ai < 2; ++ai) {
            const int G = ai * 2 + wr;
            float p1[8], p2[8];
            if (G > 0) {
                PG8_LAS float* h = halo + ((((G - 1) * 4 + wc) * 2) * 32 + fq * 8);
                const f32x4 r62a = *(PG8_LAS f32x4*)h, r62b = *(PG8_LAS f32x4*)(h + 4), r63a = *(PG8_LAS f32x4*)(h + 32), r63b = *(PG8_LAS f32x4*)(h + 36);
#pragma unroll
                for (int j = 0; j < 4; ++j) { p1[j] = r63a[j]; p1[4 + j] = r63b[j]; p2[j] = fr == 0 ? r62a[j] : r63a[j]; p2[4 + j] = fr == 0 ? r62b[j] : r63b[j]; }
            } else {
#pragma unroll
                for (int j = 0; j < 8; ++j) { p1[j] = 0.f; p2[j] = 0.f; }
            }
#pragma unroll
            for (int m = 0; m < 4; ++m) {
                float gv[8], uv[8];
#pragma unroll
                for (int j = 0; j < 4; ++j) { gv[j] = acc[ai][0][m][0][j]; gv[4 + j] = acc[ai][0][m][1][j]; uv[j] = acc[ai][1][m][0][j]; uv[4 + j] = acc[ai][1][m][1][j]; }
                float o8[8];
#pragma unroll
                for (int j = 0; j < 8; ++j) {
                    const float r1 = __builtin_bit_cast(float, __builtin_amdgcn_update_dpp(0, __builtin_bit_cast(int, gv[j]), 0x121, 0xf, 0xf, false));
                    const float r2 = __builtin_bit_cast(float, __builtin_amdgcn_update_dpp(0, __builtin_bit_cast(int, gv[j]), 0x122, 0xf, 0xf, false));
                    const float g1 = fr >= 1 ? r1 : p1[j], g2 = fr >= 2 ? r2 : p2[j];
                    o8[j] = gelu_tanh_f(w0[j] * g2 + w1[j] * g1 + w2[j] * gv[j] + bb[j]) * uv[j];
                    p1[j] = r1; p2[j] = r2;
                }
                const int row = u.pm * BM + ai * HALF + wr * 64 + m * 16 + fr;
                const bool first2 = (G == 0 && m == 0 && fr < 2), last2 = (G == 3 && m == 3 && fr >= 14);
                if (!first2) { u32x4 w; w.x = pkh(o8[0], o8[1]); w.y = pkh(o8[2], o8[3]); w.z = pkh(o8[4], o8[5]); w.w = pkh(o8[6], o8[7]); *(u32x4*)(act + (size_t)row * DFF + j0) = w; }
                if (first2 || last2) {
                    float* gp = gb + ((size_t)u.pm * 4 + (first2 ? fr : 2 + fr - 14)) * DFF + j0;
                    *(f32x4*)gp = (f32x4){gv[0], gv[1], gv[2], gv[3]}; *(f32x4*)(gp + 4) = (f32x4){gv[4], gv[5], gv[6], gv[7]};
                    if (first2) { float* up = ub + ((size_t)u.pm * 2 + fr) * DFF + j0; *(f32x4*)up = (f32x4){uv[0], uv[1], uv[2], uv[3]}; *(f32x4*)(up + 4) = (f32x4){uv[4], uv[5], uv[6], uv[7]}; }
                }
            }
        }
    }
};

template <class Epi>
__device__ __forceinline__ void gemm_phase(PG8_LAS unsigned char* lds, const Gemm g, const StaticOrder& S_, const Epi& E) {
    int tid_ = threadIdx.x; asm volatile("" : "+v"(tid_));
    const int tid = tid_, wid = __builtin_amdgcn_readfirstlane(tid >> 6), lane = tid & 63, wr = wid >> 2, wc = wid & 3, fr = lane & 15, fq = lane >> 4;
    const int K = g.K, nt = K / BK, lda = g.lda;
    unsigned voffA[2], voffB[2];
#pragma unroll
    for (int i = 0; i < 2; ++i) { int R, C; stage_rc(tid * 16 + i * 8192, R, C); const int Rb = Epi::PERM ? ((R & ~31) + perm32(R & 31)) : R;
        voffA[i] = (unsigned)(R * lda + C) * 2u; voffB[i] = (unsigned)(Rb * K + C) * 2u; }
    const size_t kstep = (size_t)(BK * 2);
    const size_t hstepA = (size_t)HALF * lda * 2, hstepB = (size_t)HALF * K * 2;
    const size_t tstepA = 2 * hstepA, tstepB = 2 * hstepB;
    const unsigned ldsw = (unsigned)wid * 1024u;
    const int aoff = lds_byte(wr * 64 + fr, fq * 8), boff = lds_byte(wc * 32 + fr, fq * 8);
#define PG8_SA(b, h) (((b) * 2 + (h)) * HTB)
#define PG8_SB(b, h) ((4 + (b) * 2 + (h)) * HTB)
#define PG8_STAGE(bufoff, gbase, voff) do { _Pragma("unroll") for (int _i = 0; _i < 2; ++_i) \
        __builtin_amdgcn_global_load_lds((const unsigned*)((const char*)(gbase) + (voff)[_i]), (PG8_LAS unsigned*)(lds + (bufoff) + ldsw + _i * 8192), 16, 0, 0); } while (0)
#define PG8_LDA(dst, b, h) do { _Pragma("unroll") for (int m = 0; m < 4; ++m) _Pragma("unroll") for (int k = 0; k < 2; ++k) dst[m][k] = *(const PG8_LAS half8*)(lds + PG8_SA(b, h) + aoff + m * 2048 + k * 1024); } while (0)
#define PG8_LDB(dst, b, h) do { _Pragma("unroll") for (int n = 0; n < 2; ++n) _Pragma("unroll") for (int k = 0; k < 2; ++k) dst[n][k] = *(const PG8_LAS half8*)(lds + PG8_SB(b, h) + boff + n * 2048 + k * 1024); } while (0)
#define PG8_MMA(ai, bj, At, Bt) do { __builtin_amdgcn_s_setprio(1); _Pragma("unroll") for (int m = 0; m < 4; ++m) _Pragma("unroll") for (int n = 0; n < 2; ++n) _Pragma("unroll") for (int k = 0; k < 2; ++k) \
        acc[ai][bj][m][n] = __builtin_amdgcn_mfma_f32_16x16x32_f16(Bt[n][k], At[m][k], acc[ai][bj][m][n], 0, 0, 0); __builtin_amdgcn_s_setprio(0); } while (0)
#define PG8_WAIT_V(n) asm volatile("s_waitcnt vmcnt(" #n ")" ::: "memory")
#define PG8_WAIT_L(n) asm volatile("s_waitcnt lgkmcnt(" #n ")" ::: "memory")
#define PG8_BAR __builtin_amdgcn_s_barrier()
#define PG8_SCHED __builtin_amdgcn_sched_barrier(0)
    Unit cur, nxt; int ui = 0;
    if (!S_.next(0, cur)) return;
    f32x4 acc[2][2][4][2];
#pragma unroll
    for (int a = 0; a < 2; ++a)
#pragma unroll
        for (int b = 0; b < 2; ++b)
#pragma unroll
            for (int m = 0; m < 4; ++m)
#pragma unroll
                for (int n = 0; n < 2; ++n) acc[a][b][m][n] = (f32x4){0.f, 0.f, 0.f, 0.f};
    half8 At[4][2], B0[2][2], B1[2][2];
    const char* cA = (const char*)g.A + (size_t)cur.pm * tstepA; const char* cB = (const char*)g.Bt + (size_t)cur.pn * tstepB;
    PG8_STAGE(PG8_SB(0, 0), cB, voffB); PG8_STAGE(PG8_SB(0, 1), cB + hstepB, voffB); PG8_STAGE(PG8_SA(0, 0), cA, voffA); PG8_STAGE(PG8_SA(0, 1), cA + hstepA, voffA);
    if (wr == 1) PG8_BAR;
    PG8_WAIT_V(2); PG8_BAR;
    PG8_STAGE(PG8_SB(1, 0), cB + kstep, voffB); PG8_STAGE(PG8_SA(1, 0), cA + kstep, voffA); PG8_STAGE(PG8_SB(1, 1), cB + hstepB + kstep, voffB);
    PG8_WAIT_V(6); PG8_BAR;
    for (;;) {
        const bool has_next = S_.next(ui + 1, nxt);
        const char* nA = has_next ? (const char*)g.A + (size_t)nxt.pm * tstepA : cA; const char* nB = has_next ? (const char*)g.Bt + (size_t)nxt.pn * tstepB : cB;
        for (int t = 0; t < nt; t += 2) {
            const bool last = (t == nt - 2);
            const char* a1 = cA + (size_t)(t + 1) * kstep;
            const char* a2 = last ? nA : cA + (size_t)(t + 2) * kstep; const char* b2 = last ? nB : cB + (size_t)(t + 2) * kstep;
            const char* a3 = a2 + kstep; const char* b3 = b2 + kstep;
            PG8_LDB(B0, 0, 0); PG8_LDB(B1, 0, 1); PG8_SCHED; PG8_LDA(At, 0, 0); PG8_STAGE(PG8_SA(1, 1), a1 + hstepA, voffA);
            PG8_WAIT_V(8); PG8_WAIT_L(0); PG8_BAR; PG8_MMA(0, 0, At, B0); PG8_MMA(0, 1, At, B1); PG8_BAR; PG8_SCHED;
            PG8_LDA(At, 0, 1); PG8_STAGE(PG8_SB(0, 0), b2, voffB); PG8_STAGE(PG8_SB(0, 1), b2 + hstepB, voffB); PG8_STAGE(PG8_SA(0, 0), a2, voffA);
            PG8_WAIT_V(8); PG8_WAIT_L(0); PG8_BAR; PG8_MMA(1, 0, At, B0); PG8_MMA(1, 1, At, B1); PG8_BAR; PG8_SCHED;
            PG8_LDB(B0, 1, 0); PG8_LDB(B1, 1, 1); PG8_SCHED; PG8_LDA(At, 1, 0); PG8_STAGE(PG8_SA(0, 1), a2 + hstepA, voffA);
            PG8_WAIT_V(8); PG8_WAIT_L(0); PG8_BAR; PG8_MMA(0, 0, At, B0); PG8_MMA(0, 1, At, B1); PG8_BAR; PG8_SCHED;
            PG8_LDA(At, 1, 1); PG8_STAGE(PG8_SB(1, 0), b3, voffB); PG8_STAGE(PG8_SB(1, 1), b3 + hstepB, voffB); PG8_STAGE(PG8_SA(1, 0), a3, voffA);
            PG8_WAIT_V(8); PG8_WAIT_L(0); PG8_BAR; PG8_MMA(1, 0, At, B0); PG8_MMA(1, 1, At, B1); PG8_BAR; PG8_SCHED;
        }
        if (wr == 0) PG8_BAR;
        E(acc, cur, wr, wc, fr, fq, lds);
        if (!has_next) break;
#pragma unroll
        for (int a = 0; a < 2; ++a)
#pragma unroll
            for (int b = 0; b < 2; ++b)
#pragma unroll
                for (int m = 0; m < 4; ++m)
#pragma unroll
                    for (int n = 0; n < 2; ++n) acc[a][b][m][n] = (f32x4){0.f, 0.f, 0.f, 0.f};
        cur = nxt; cA = nA; cB = nB; ++ui;
        if (wr == 1) PG8_BAR;
    }
    PG8_WAIT_V(0);
    PG8_BAR;
#undef PG8_SA
#undef PG8_SB
#undef PG8_STAGE
#undef PG8_LDA
#undef PG8_LDB
#undef PG8_MMA
#undef PG8_WAIT_V
#undef PG8_WAIT_L
#undef PG8_BAR
#undef PG8_SCHED
}
}

struct Args {
    const float* x; const float* c; const int* positions; const float* w_in; const float* w_out; const float* w_ada; const float* b_ada; const float* norm_w;
    const float* cmp_w_k; const float* cmp_w_v; const float* cmp_pe_k; const float* cmp_pe_v; const float* sinks; const float* w_gate; const float* w_up;
    const float* conv_w; const float* conv_b; const float* w_down;
    float* out; unsigned char* ws;
    float inv_freq[32];
};

#define LDS_WAIT() asm volatile("s_waitcnt lgkmcnt(0)" ::: "memory")
#define MFMA16(a, b, c) __builtin_amdgcn_mfma_f32_16x16x32_f16((a), (b), (c), 0, 0, 0)
__device__ __forceinline__ float shx(float v, int m) { return __shfl_xor(v, m); }
__device__ __forceinline__ float wave_sum(float v) {
#pragma unroll
    for (int o = 1; o < 64; o <<= 1) v += __shfl_xor(v, o);
    return v;
}
__device__ __forceinline__ int rope_perm(int o) { return 16 * (o >> 5) + 4 * ((o >> 3) & 3) + (o & 3) + 32 * ((o >> 2) & 1); }
__device__ __forceinline__ int win_src_col(int p) {
    const int s = p >> 6, o = p & 63; int base;
    if (s < 10) base = 64 * s; else if (s < 38) base = 652 + 64 * (s - 10); else if (s == 38) return o < 12 ? 640 + o : -1; else return -1;
    const bool rope = (s < 5) || s == 6 || s == 8 || (s >= 10 && s < 22) || (s >= 28 && s < 36);
    return base + (rope ? rope_perm(o) : o);
}

template <bool KPERM = false, class SrcF>
__device__ __forceinline__ void transpose_item(const float* W, int ldw, int K, half_t* WT, int nblk, float* scr, int item, int lane, SrcF src) {
    const int kb = item / nblk, nb = item % nblk, k0 = 64 * kb, n0 = 32 * nb;
    const int sc = src(n0 + (lane & 31));
#pragma unroll 8
    for (int i = 0; i < 32; ++i) { const int kk = 2 * i + (lane >> 5); scr[kk * 33 + (lane & 31)] = sc >= 0 ? W[(size_t)(k0 + (KPERM ? rope_perm(kk) : kk)) * ldw + sc] : 0.f; }
    LDS_WAIT();
    const int c = lane & 7;
#pragma unroll
    for (int j = 0; j < 4; ++j) { const int n = (lane >> 3) + 8 * j; const float* s = scr + (8 * c) * 33 + n;
        u32x4 o; o.x = pg8::pkh(s[0 * 33], s[1 * 33]); o.y = pg8::pkh(s[2 * 33], s[3 * 33]); o.z = pg8::pkh(s[4 * 33], s[5 * 33]); o.w = pg8::pkh(s[6 * 33], s[7 * 33]);
        *(u32x4*)(WT + (size_t)(n0 + n) * K + k0 + 8 * c) = o; }
    LDS_WAIT();
}

template <bool HAS_H, bool HAS_XN, int XL, int XS>
__device__ __forceinline__ void rowwise_phase(const float* xf, half_t* x16, float* xo, const half_t* hs, const float* nwA, const float* gvec, const float* nwB, const float* scv, const float* shv, half_t* xn, int gw, int NW, int lane) {
    for (int b = 0; b < NBATCH; ++b) {
        f32x4 wA[4], gg[4], wB[4], sc1[4], sh[4];
#pragma unroll
        for (int j = 0; j < 4; ++j) {
            if (HAS_H) { wA[j] = *((const f32x4*)nwA + lane + 64 * j); gg[j] = *((const f32x4*)(gvec + (size_t)b * 6144) + lane + 64 * j); }
            if (HAS_XN) { wB[j] = *((const f32x4*)nwB + lane + 64 * j); sc1[j] = *((const f32x4*)(scv + (size_t)b * 6144) + lane + 64 * j) + 1.0f; sh[j] = *((const f32x4*)(shv + (size_t)b * 6144) + lane + 64 * j); }
        }
        const int mend = (b + 1) * S;
        f32x4 xq[4]; half4 xh[4], hq[4];
        {
            const int m0 = b * S + gw;
            if (m0 < mend) {
                if (XL == 0) { const f32x4* xr = (const f32x4*)(xf + (size_t)m0 * D) + lane;
#pragma unroll
                    for (int j = 0; j < 4; ++j) xq[j] = xr[64 * j]; }
                else { const half4* xr = (const half4*)(x16 + (size_t)m0 * D) + lane;
#pragma unroll
                    for (int j = 0; j < 4; ++j) xh[j] = xr[64 * j]; }
                if (HAS_H) { const half4* hr = (const half4*)(hs + (size_t)m0 * D) + lane;
#pragma unroll
                    for (int j = 0; j < 4; ++j) hq[j] = hr[64 * j]; }
            }
        }
        for (int m = b * S + gw; m < mend; m += NW) {
            f32x4 xv[4]; half4 hcur[4];
#pragma unroll
            for (int j = 0; j < 4; ++j) { if (XL == 0) xv[j] = xq[j]; else xv[j] = (f32x4){(float)xh[j][0], (float)xh[j][1], (float)xh[j][2], (float)xh[j][3]}; if (HAS_H) hcur[j] = hq[j]; }
            const int mn = (m + NW < mend) ? m + NW : m;
            {
                if (XL == 0) { const f32x4* xr = (const f32x4*)(xf + (size_t)mn * D) + lane;
#pragma unroll
                    for (int j = 0; j < 4; ++j) xq[j] = xr[64 * j]; }
                else { const half4* xr = (const half4*)(x16 + (size_t)mn * D) + lane;
#pragma unroll
                    for (int j = 0; j < 4; ++j) xh[j] = xr[64 * j]; }
                if (HAS_H) { const half4* hr = (const half4*)(hs + (size_t)mn * D) + lane;
#pragma unroll
                    for (int j = 0; j < 4; ++j) hq[j] = hr[64 * j]; }
            }
            if (HAS_H) {
                f32x4 hv[4]; float ss = 0.f;
#pragma unroll
                for (int j = 0; j < 4; ++j) { const half4 h4 = hcur[j]; hv[j] = (f32x4){(float)h4[0], (float)h4[1], (float)h4[2], (float)h4[3]}; ss += (hv[j][0] * hv[j][0] + hv[j][1] * hv[j][1]) + (hv[j][2] * hv[j][2] + hv[j][3] * hv[j][3]); }
                const float r = 1.0f / sqrtf(wave_sum(ss) * (1.f / D) + RMS_EPS);
#pragma unroll
                for (int j = 0; j < 4; ++j) xv[j] = xv[j] + gg[j] * (hv[j] * r * wA[j]);
            }
            if (XS == 1) {
                u32x2* xs = (u32x2*)(x16 + (size_t)m * D) + lane;
#pragma unroll
                for (int j = 0; j < 4; ++j) { u32x2 pk; pk.x = pg8::pkh(xv[j][0], xv[j][1]); pk.y = pg8::pkh(xv[j][2], xv[j][3]); xs[64 * j] = pk; }
            } else if (XS == 2) {
                f32x4* xs = (f32x4*)(xo + (size_t)m * D) + lane;
#pragma unroll
                for (int j = 0; j < 4; ++j) xs[64 * j] = xv[j];
            }
            if (HAS_XN) {
                float ss = 0.f;
#pragma unroll
                for (int j = 0; j < 4; ++j) ss += (xv[j][0] * xv[j][0] + xv[j][1] * xv[j][1]) + (xv[j][2] * xv[j][2] + xv[j][3] * xv[j][3]);
                const float r = 1.0f / sqrtf(wave_sum(ss) * (1.f / D) + RMS_EPS);
                u32x2* xo2 = (u32x2*)(xn + (size_t)m * D) + lane;
#pragma unroll
                for (int j = 0; j < 4; ++j) { const f32x4 o = (xv[j] * r * wB[j]) * sc1[j] + sh[j]; u32x2 pk; pk.x = pg8::pkh(o[0], o[1]); pk.y = pg8::pkh(o[2], o[3]); xo2[64 * j] = pk; }
            }
        }
    }
}

template <bool PV, class MK>
__device__ __forceinline__ void attn_run(int kb0, int kb_last, const half8 q0, const half8 q1, const half_t* kf, const half_t* vf, MK valid, f32x4 (&o)[4], float& m, float& l, int g) {
    for (int kb = kb0; kb <= kb_last; kb += 32) {
        const half_t* kp = kf + (size_t)(kb >> 5) * 2048;
        const half8 a00 = *(const half8*)kp, a01 = *(const half8*)(kp + 512), a10 = *(const half8*)(kp + 1024), a11 = *(const half8*)(kp + 1536);
        half8 vfr[4];
        if (PV) { const half_t* vp = vf + (size_t)(kb >> 5) * 2048;
#pragma unroll
            for (int dt = 0; dt < 4; ++dt) vfr[dt] = *(const half8*)(vp + dt * 512); }
        const f32x4 z = {0.f, 0.f, 0.f, 0.f};
        f32x4 s0 = MFMA16(a00, q0, z); s0 = MFMA16(a01, q1, s0);
        f32x4 s1 = MFMA16(a10, q0, z); s1 = MFMA16(a11, q1, s1);
        bool v0[4], v1[4]; float mx = -1e30f;
#pragma unroll
        for (int r = 0; r < 4; ++r) { const int key = kb + 4 * g + r; v0[r] = valid(key); v1[r] = valid(key + 16); if (v0[r]) mx = fmaxf(mx, s0[r]); if (v1[r]) mx = fmaxf(mx, s1[r]); }
        mx = fmaxf(mx, shx(mx, 16)); mx = fmaxf(mx, shx(mx, 32));
        const float mn = fmaxf(m, mx); const float corr = __builtin_amdgcn_exp2f(m - mn); m = mn;
        float p0[4], p1[4], ps = 0.f;
#pragma unroll
        for (int r = 0; r < 4; ++r) { p0[r] = v0[r] ? __builtin_amdgcn_exp2f(s0[r] - mn) : 0.f; p1[r] = v1[r] ? __builtin_amdgcn_exp2f(s1[r] - mn) : 0.f; ps += p0[r] + p1[r]; }
        l = l * corr + ps;
        if (PV) {
            const half8 pf = {(half_t)p0[0], (half_t)p0[1], (half_t)p0[2], (half_t)p0[3], (half_t)p1[0], (half_t)p1[1], (half_t)p1[2], (half_t)p1[3]};
#pragma unroll
            for (int dt = 0; dt < 4; ++dt) { o[dt] = o[dt] * corr; o[dt] = MFMA16(vfr[dt], pf, o[dt]); }
        }
    }
}

constexpr float RESC_THR = 12.0f;
template <int MODE, bool PV, class MK, class KB>
__device__ __forceinline__ void attn_run2(int nit, KB kbof, int maxblk, const half8 q0, const half8 q1, const half_t* kf, const half_t* vf, MK valid, f32x4 (&o)[4], float& m, float& l, int g,
                                          float* impq = nullptr, bool impw = false, int lane = 0) {
    if (nit <= 0) return;
    half8 ka[8], va[8];
    int kbA = kbof(0);
    {
        const int bA = kbA >> 5, bB = (bA + 1 <= maxblk) ? bA + 1 : maxblk;
        const half_t* kpA = kf + (size_t)bA * 2048; const half_t* kpB = kf + (size_t)bB * 2048;
#pragma unroll
        for (int i = 0; i < 4; ++i) { ka[i] = *(const half8*)(kpA + i * 512); ka[4 + i] = *(const half8*)(kpB + i * 512); }
        if (PV) { const half_t* vpA = vf + (size_t)bA * 2048; const half_t* vpB = vf + (size_t)bB * 2048;
#pragma unroll
            for (int i = 0; i < 4; ++i) { va[i] = *(const half8*)(vpA + i * 512); va[4 + i] = *(const half8*)(vpB + i * 512); } }
    }
    float carry = 0.f;
    for (int it = 0; it < nit; ++it) {
        const int kbN = kbof((it + 1 < nit) ? it + 1 : it);
        const int nbA = kbN >> 5, nbB = (nbA + 1 <= maxblk) ? nbA + 1 : maxblk;
        const f32x4 z = {0.f, 0.f, 0.f, 0.f};
        f32x4 s[4];
#pragma unroll
        for (int t = 0; t < 4; ++t) { s[t] = MFMA16(ka[2 * t], q0, z); s[t] = MFMA16(ka[2 * t + 1], q1, s[t]); }
        {
            const half_t* kpA = kf + (size_t)nbA * 2048; const half_t* kpB = kf + (size_t)nbB * 2048;
#pragma unroll
            for (int i = 0; i < 4; ++i) { ka[i] = *(const half8*)(kpA + i * 512); ka[4 + i] = *(const half8*)(kpB + i * 512); }
        }
        float p[4][4];
        if (MODE == 0) {
            bool vld[4][4]; float mx = -1e30f;
#pragma unroll
            for (int t = 0; t < 4; ++t)
#pragma unroll
                for (int r = 0; r < 4; ++r) { vld[t][r] = valid(kbA + 16 * t + 4 * g + r); if (vld[t][r]) mx = fmaxf(mx, s[t][r]); }
            if (__ballot(mx > m + RESC_THR) != 0ull) {
                mx = fmaxf(mx, shx(mx, 16)); mx = fmaxf(mx, shx(mx, 32));
                const float mn = fmaxf(m, mx); const float corr = __builtin_amdgcn_exp2f(m - mn); m = mn;
                l = l * corr;
                if (PV) {
#pragma unroll
                    for (int dt = 0; dt < 4; ++dt) o[dt] = o[dt] * corr;
                }
            }
            float ps = 0.f;
#pragma unroll
            for (int t = 0; t < 4; ++t)
#pragma unroll
                for (int r = 0; r < 4; ++r) { p[t][r] = vld[t][r] ? __builtin_amdgcn_exp2f(s[t][r] - m) : 0.f; ps += p[t][r]; }
            l = l + ps;
        } else {
#pragma unroll
            for (int t = 0; t < 4; ++t)
#pragma unroll
                for (int r = 0; r < 4; ++r) p[t][r] = valid(kbA + 16 * t + 4 * g + r) ? __builtin_amdgcn_exp2f(s[t][r] - m) * l : 0.f;
        }
        if (PV) {
            const half8 pfA = {(half_t)p[0][0], (half_t)p[0][1], (half_t)p[0][2], (half_t)p[0][3], (half_t)p[1][0], (half_t)p[1][1], (half_t)p[1][2], (half_t)p[1][3]};
            const half8 pfB = {(half_t)p[2][0], (half_t)p[2][1], (half_t)p[2][2], (half_t)p[2][3], (half_t)p[3][0], (half_t)p[3][1], (half_t)p[3][2], (half_t)p[3][3]};
#pragma unroll
            for (int dt = 0; dt < 4; ++dt) { o[dt] = MFMA16(va[dt], pfA, o[dt]); o[dt] = MFMA16(va[4 + dt], pfB, o[dt]); }
            const half_t* vpA = vf + (size_t)nbA * 2048; const half_t* vpB = vf + (size_t)nbB * 2048;
#pragma unroll
            for (int i = 0; i < 4; ++i) { va[i] = *(const half8*)(vpA + i * 512); va[4 + i] = *(const half8*)(vpB + i * 512); }
        }
        if (MODE == 1) {
            float A[4], B[4], Bup[4], Btop[4];
#pragma unroll
            for (int t = 0; t < 4; ++t) { A[t] = (p[t][0] + p[t][1]) + (p[t][2] + p[t][3]); B[t] = p[t][3]; A[t] += shx(A[t], 1); A[t] += shx(A[t], 2); B[t] += shx(B[t], 1); B[t] += shx(B[t], 2);
                Bup[t] = __shfl(B[t], (lane - 16) & 63); Btop[t] = __shfl(B[t], (lane & 15) + 48); }
#pragma unroll
            for (int t = 0; t < 4; ++t) { const float prev = g > 0 ? Bup[t] : (t == 0 ? carry : Btop[t > 0 ? t - 1 : 0]); if (impw) impq[(kbA >> 2) + 4 * t + g] = A[t] + prev; }
            carry = Btop[3];
        }
        kbA = kbN;
    }
}

template <int NS, int MODE, class MK, class KB>
__device__ __forceinline__ void attn_runN(int nit, KB kbof, int maxblk, const half8 (&qf)[NS][2], const half_t* kf, const half_t* vf, MK valid, f32x4 (&o)[NS][4], float (&m)[NS], float (&l)[NS], int g,
                                          float* impb = nullptr, int imps = 0, bool impw = false, int lane = 0) {
    if (nit <= 0) return;
    constexpr bool PV = MODE != 2;
    half8 ka[8], va[8];
    int kbA = kbof(0);
    {
        const int bA = kbA >> 5, bB = (bA + 1 <= maxblk) ? bA + 1 : maxblk;
        const half_t* kpA = kf + (size_t)bA * 2048; const half_t* kpB = kf + (size_t)bB * 2048;
#pragma unroll
        for (int i = 0; i < 4; ++i) { ka[i] = *(const half8*)(kpA + i * 512); ka[4 + i] = *(const half8*)(kpB + i * 512); }
        if (PV) { const half_t* vpA = vf + (size_t)bA * 2048; const half_t* vpB = vf + (size_t)bB * 2048;
#pragma unroll
            for (int i = 0; i < 4; ++i) { va[i] = *(const half8*)(vpA + i * 512); va[4 + i] = *(const half8*)(vpB + i * 512); } }
    }
    float carry[NS];
#pragma unroll
    for (int s_ = 0; s_ < NS; ++s_) carry[s_] = 0.f;
    for (int it = 0; it < nit; ++it) {
        const int kbN = kbof((it + 1 < nit) ? it + 1 : it);
        const int nbA = kbN >> 5, nbB = (nbA + 1 <= maxblk) ? nbA + 1 : maxblk;
        const f32x4 z = {0.f, 0.f, 0.f, 0.f};
#pragma unroll
        for (int s_ = 0; s_ < NS; ++s_) {
            f32x4 s[4];
#pragma unroll
            for (int t = 0; t < 4; ++t) { s[t] = MFMA16(ka[2 * t], qf[s_][0], z); s[t] = MFMA16(ka[2 * t + 1], qf[s_][1], s[t]); }
            if (s_ == NS - 1) {
                const half_t* kpA = kf + (size_t)nbA * 2048; const half_t* kpB = kf + (size_t)nbB * 2048;
#pragma unroll
                for (int i = 0; i < 4; ++i) { ka[i] = *(const half8*)(kpA + i * 512); ka[4 + i] = *(const half8*)(kpB + i * 512); }
            }
            if (MODE != 1) {
                float mx = -1e30f;
#pragma unroll
                for (int t = 0; t < 4; ++t)
#pragma unroll
                    for (int r = 0; r < 4; ++r) { if (valid(s_, kbA + 16 * t + 4 * g + r)) mx = fmaxf(mx, s[t][r]); }
                if (__ballot(mx > m[s_] + RESC_THR) != 0ull) {
                    mx = fmaxf(mx, shx(mx, 16)); mx = fmaxf(mx, shx(mx, 32));
                    const float mn = fmaxf(m[s_], mx); const float corr = __builtin_amdgcn_exp2f(m[s_] - mn); m[s_] = mn; l[s_] = l[s_] * corr;
                    if (PV) {
#pragma unroll
                        for (int dt = 0; dt < 4; ++dt) o[s_][dt] = o[s_][dt] * corr;
                    }
                }
            }
            float p[4][4]; float ps = 0.f;
#pragma unroll
            for (int t = 0; t < 4; ++t)
#pragma unroll
                for (int r = 0; r < 4; ++r) { p[t][r] = valid(s_, kbA + 16 * t + 4 * g + r) ? __builtin_amdgcn_exp2f(s[t][r] - m[s_]) : 0.f; if (MODE == 1) p[t][r] *= l[s_]; ps += p[t][r]; }
            if (MODE != 1) l[s_] = l[s_] + ps;
            if (PV) {
                const half8 pfA = {(half_t)p[0][0], (half_t)p[0][1], (half_t)p[0][2], (half_t)p[0][3], (half_t)p[1][0], (half_t)p[1][1], (half_t)p[1][2], (half_t)p[1][3]};
                const half8 pfB = {(half_t)p[2][0], (half_t)p[2][1], (half_t)p[2][2], (half_t)p[2][3], (half_t)p[3][0], (half_t)p[3][1], (half_t)p[3][2], (half_t)p[3][3]};
#pragma unroll
                for (int dt = 0; dt < 4; ++dt) { o[s_][dt] = MFMA16(va[dt], pfA, o[s_][dt]); o[s_][dt] = MFMA16(va[4 + dt], pfB, o[s_][dt]); }
            }
            if (MODE == 1) {
                float A[4], B[4], Bup[4], Btop[4];
#pragma unroll
                for (int t = 0; t < 4; ++t) { A[t] = (p[t][0] + p[t][1]) + (p[t][2] + p[t][3]); B[t] = p[t][3]; A[t] += shx(A[t], 1); A[t] += shx(A[t], 2); B[t] += shx(B[t], 1); B[t] += shx(B[t], 2);
                    Bup[t] = __shfl(B[t], (lane - 16) & 63); Btop[t] = __shfl(B[t], (lane & 15) + 48); }
#pragma unroll
                for (int t = 0; t < 4; ++t) { const float prev = g > 0 ? Bup[t] : (t == 0 ? carry[s_] : Btop[t > 0 ? t - 1 : 0]); if (impw) impb[s_ * imps + (kbA >> 2) + 4 * t + g] = A[t] + prev; }
                carry[s_] = Btop[3];
            }
        }
        if (PV) {
            const half_t* vpA = vf + (size_t)nbA * 2048; const half_t* vpB = vf + (size_t)nbB * 2048;
#pragma unroll
            for (int i = 0; i < 4; ++i) { va[i] = *(const half8*)(vpA + i * 512); va[4 + i] = *(const half8*)(vpB + i * 512); }
        }
        kbA = kbN;
    }
}

__device__ __forceinline__ half8 fp8x8_to_half8(u32x2 x) {
    const half2v a = __builtin_amdgcn_cvt_scalef32_pk_f16_fp8((int)x.x, 1.0f, false), b = __builtin_amdgcn_cvt_scalef32_pk_f16_fp8((int)x.x, 1.0f, true);
    const half2v c = __builtin_amdgcn_cvt_scalef32_pk_f16_fp8((int)x.y, 1.0f, false), d = __builtin_amdgcn_cvt_scalef32_pk_f16_fp8((int)x.y, 1.0f, true);
    return (half8){a.x, a.y, b.x, b.y, c.x, c.y, d.x, d.y};
}
template <class KB>
__device__ __forceinline__ void sel_run(int nit, KB kbof, const half8 (&qf)[2][2], const unsigned char* kf, const unsigned char* vf, const int (&tqs)[2], int qq,
                                        f32x4 (&o)[2][4], float (&m)[2], float (&l)[2], int g) {
    if (nit <= 0) return;
    u32x2 ka[8], va[8];
    int eA = kbof(0);
    int kbA = 64 * (eA & 255);
    {
        const unsigned char* kp = kf + (size_t)(kbA >> 5) * 2048; const unsigned char* vp = vf + (size_t)(kbA >> 5) * 2048;
#pragma unroll
        for (int i = 0; i < 8; ++i) { ka[i] = *(const u32x2*)(kp + i * 512); va[i] = *(const u32x2*)(vp + i * 512); }
    }
    for (int it = 0; it < nit; ++it) {
        const int eN = kbof((it + 1 < nit) ? it + 1 : it);
        const int kbN = 64 * (eN & 255);
        const unsigned maskA = (unsigned)eA >> 8;
        bool selq[2], need[2];
#pragma unroll
        for (int s_ = 0; s_ < 2; ++s_) { selq[s_] = ((maskA >> (4 * s_ + qq)) & 1u) != 0u; need[s_] = ((maskA >> (4 * s_)) & 15u) != 0u; }
        half8 kh[8];
#pragma unroll
        for (int i = 0; i < 8; ++i) kh[i] = fp8x8_to_half8(ka[i]);
        {
            const unsigned char* kp = kf + (size_t)(kbN >> 5) * 2048;
#pragma unroll
            for (int i = 0; i < 8; ++i) ka[i] = *(const u32x2*)(kp + i * 512);
        }
        const f32x4 z = {0.f, 0.f, 0.f, 0.f};
        f32x4 s[2][4];
#pragma unroll
        for (int s_ = 0; s_ < 2; ++s_)
            if (need[s_]) {
#pragma unroll
                for (int t = 0; t < 4; ++t) { s[s_][t] = MFMA16(kh[2 * t], qf[s_][0], z); s[s_][t] = MFMA16(kh[2 * t + 1], qf[s_][1], s[s_][t]); }
            }
        half8 vh[8];
#pragma unroll
        for (int i = 0; i < 8; ++i) vh[i] = fp8x8_to_half8(va[i]);
        {
            const unsigned char* vp = vf + (size_t)(kbN >> 5) * 2048;
#pragma unroll
            for (int i = 0; i < 8; ++i) va[i] = *(const u32x2*)(vp + i * 512);
        }
#pragma unroll
        for (int s_ = 0; s_ < 2; ++s_)
            if (need[s_]) {
                float p[4][4]; bool vld[4][4]; float mx = -1e30f;
#pragma unroll
                for (int t = 0; t < 4; ++t)
#pragma unroll
                    for (int r = 0; r < 4; ++r) { vld[t][r] = selq[s_] && (kbA + 16 * t + 4 * g + r <= tqs[s_]); if (vld[t][r]) mx = fmaxf(mx, s[s_][t][r]); }
                if (__ballot(mx > m[s_] + RESC_THR) != 0ull) {
                    mx = fmaxf(mx, shx(mx, 16)); mx = fmaxf(mx, shx(mx, 32));
                    const float mn = fmaxf(m[s_], mx); const float corr = __builtin_amdgcn_exp2f(m[s_] - mn); m[s_] = mn;
                    l[s_] = l[s_] * corr;
#pragma unroll
                    for (int dt = 0; dt < 4; ++dt) o[s_][dt] = o[s_][dt] * corr;
                }
                float ps = 0.f;
#pragma unroll
                for (int t = 0; t < 4; ++t)
#pragma unroll
                    for (int r = 0; r < 4; ++r) { p[t][r] = vld[t][r] ? __builtin_amdgcn_exp2f(s[s_][t][r] - m[s_]) : 0.f; ps += p[t][r]; }
                l[s_] = l[s_] + ps;
                const half8 pfA = {(half_t)p[0][0], (half_t)p[0][1], (half_t)p[0][2], (half_t)p[0][3], (half_t)p[1][0], (half_t)p[1][1], (half_t)p[1][2], (half_t)p[1][3]};
                const half8 pfB = {(half_t)p[2][0], (half_t)p[2][1], (half_t)p[2][2], (half_t)p[2][3], (half_t)p[3][0], (half_t)p[3][1], (half_t)p[3][2], (half_t)p[3][3]};
#pragma unroll
                for (int dt = 0; dt < 4; ++dt) { o[s_][dt] = MFMA16(vh[dt], pfA, o[s_][dt]); o[s_][dt] = MFMA16(vh[4 + dt], pfB, o[s_][dt]); }
            }
        kbA = kbN; eA = eN;
    }
}

struct ACtx { const half_t* proj; const half_t* kc; const half_t* vct; const half_t* vt; const half_t* kf; half_t* mix; float* lse; const float* sinks; const unsigned char* ks8; const unsigned char* vs8; };

__device__ __forceinline__ void a_unit(const ACtx& X, int b, int t0, float* ldsw, int lane) {
    const int c = lane & 15, g = lane >> 4, loff = (c * 4 + g) * 8;
    float* outT = ldsw;
    float* impL = ldsw + 2048;
    unsigned* qbits = (unsigned*)(ldsw + 4096);
    int* ulist = (int*)(ldsw + 4160);
    const size_t rowb = (size_t)b * S;
    const half_t* P = X.proj;
    qbits[lane] = 0u;
    for (int i = lane; i < 2048; i += 64) impL[i] = 0.f;
    {
        const int qq = c >> 2, h = c & 3;
        half8 qf[2][2]; int tqs[2], nval[2];
#pragma unroll
        for (int s_ = 0; s_ < 2; ++s_) { tqs[s_] = t0 + 4 * s_ + qq; nval[s_] = (tqs[s_] >= 31) ? ((tqs[s_] - 31) >> 4) : -1;
            const half_t* qrow = P + (rowb + tqs[s_]) * NPROJ + h * 64; qf[s_][0] = *(const half8*)(qrow + 8 * g); qf[s_][1] = *(const half8*)(qrow + 32 + 8 * g); }
        const int tqmax = t0 + 7;
        const int nlast = (tqmax >= 31) ? ((tqmax - 31) >> 4) : -1;
        const half_t* kcb = X.kc + (size_t)b * 1024 * 64 + loff;
        const half_t* vcb = X.vct + (size_t)b * 64 * 1024 + loff;
        auto valid = [&](int s_, int n) { return n <= nval[s_]; };
        float m[2] = {-1e30f, -1e30f}, l[2] = {0.f, 0.f}; f32x4 o[2][4];
#pragma unroll
        for (int s_ = 0; s_ < 2; ++s_)
#pragma unroll
            for (int dt = 0; dt < 4; ++dt) o[s_][dt] = (f32x4){0.f, 0.f, 0.f, 0.f};
        const int nitc = (nlast >= 0) ? ((nlast >> 6) + 1) : 0;
        auto kbc = [&](int it) { return 64 * it; };
        attn_runN<2, 2>(nitc, kbc, 31, qf, kcb, vcb, valid, o, m, l, g);
#pragma unroll
        for (int s_ = 0; s_ < 2; ++s_) { float ls = l[s_]; ls += shx(ls, 16); ls += shx(ls, 32); l[s_] = ls > 0.f ? 1.f / ls : 0.f; }
        attn_runN<2, 1>(nitc, kbc, 31, qf, kcb, vcb, valid, o, m, l, g, impL + qq * 256, 1024, h == 0, lane);
#pragma unroll
        for (int s_ = 0; s_ < 2; ++s_) {
            const float gc = (float)P[(rowb + tqs[s_]) * NPROJ + 38 * 64 + h * 3 + 0];
#pragma unroll
            for (int dt = 0; dt < 4; ++dt)
#pragma unroll
                for (int r = 0; r < 4; ++r) outT[((4 * s_ + qq) * 4 + h) * 64 + 16 * dt + 4 * g + r] = gc * o[s_][dt][r];
        }
    }
    LDS_WAIT(); __builtin_amdgcn_wave_barrier();
    for (int qi = 0; qi < 8; ++qi) {
        const int tqq = t0 + qi, cur = tqq >> 6, cnt = (cur + 1 < 16) ? cur + 1 : 16;
        unsigned key[4];
#pragma unroll
        for (int i = 0; i < 4; ++i) { const int j = lane + 64 * i; const float v = (j == 0 || j == cur || j == cur - 1) ? 1e4f : fmaxf(impL[qi * 256 + j], 0.f); key[i] = (j > cur) ? 0u : (__float_as_uint(v) + 1u); }
        unsigned T = 0u;
        for (int bit = 30; bit >= 0; --bit) {
            const unsigned cand = T | (1u << bit);
            int cge = 0;
#pragma unroll
            for (int i = 0; i < 4; ++i) cge += __popcll(__ballot(key[i] >= cand));
            if (cge >= cnt) T = cand;
        }
        int ngt = 0;
#pragma unroll
        for (int i = 0; i < 4; ++i) ngt += __popcll(__ballot(key[i] > T));
        int need = cnt - ngt, base = 0;
#pragma unroll
        for (int i = 0; i < 4; ++i) {
            const unsigned long long Me = __ballot(key[i] == T);
            const int pos = base + (int)__builtin_amdgcn_mbcnt_hi((unsigned)(Me >> 32), __builtin_amdgcn_mbcnt_lo((unsigned)Me, 0u));
            const bool sel = (key[i] > T) || (key[i] == T && pos < need);
            const unsigned long long Ms = __ballot(sel);
            if (lane == 0) { qbits[qi * 8 + 2 * i] = (unsigned)Ms; qbits[qi * 8 + 2 * i + 1] = (unsigned)(Ms >> 32); }
            base += __popcll(Me);
        }
    }
    LDS_WAIT(); __builtin_amdgcn_wave_barrier();
    {
        int nun = 0;
#pragma unroll
        for (int i = 0; i < 4; ++i) {
            const int j = lane + 64 * i, w = j >> 5; unsigned u = 0u;
#pragma unroll
            for (int q = 0; q < 8; ++q) u |= ((qbits[q * 8 + w] >> (j & 31)) & 1u) << q;
            const bool pr = u != 0u;
            const unsigned long long Mb = __ballot(pr);
            const int pos = nun + (int)__builtin_amdgcn_mbcnt_hi((unsigned)(Mb >> 32), __builtin_amdgcn_mbcnt_lo((unsigned)Mb, 0u));
            if (pr) ulist[pos] = j | (int)(u << 8);
            nun += __popcll(Mb);
        }
        LDS_WAIT(); __builtin_amdgcn_wave_barrier();
        const int qq = c >> 2, h = c & 3;
        half8 qf[2][2]; int tqs[2];
#pragma unroll
        for (int s_ = 0; s_ < 2; ++s_) { tqs[s_] = t0 + 4 * s_ + qq; const half_t* qrow = P + (rowb + tqs[s_]) * NPROJ + h * 64; qf[s_][0] = *(const half8*)(qrow + 8 * g); qf[s_][1] = *(const half8*)(qrow + 32 + 8 * g); }
        const unsigned char* kb_ = X.ks8 + (size_t)b * 64 * S + loff;
        const unsigned char* vb_ = X.vs8 + (size_t)b * 64 * S + loff;
        f32x4 o[2][4]; float m[2] = {-1e30f, -1e30f}, l[2] = {0.f, 0.f};
#pragma unroll
        for (int s_ = 0; s_ < 2; ++s_)
#pragma unroll
            for (int dt = 0; dt < 4; ++dt) o[s_][dt] = (f32x4){0.f, 0.f, 0.f, 0.f};
        auto kbs = [&](int it) { return __builtin_amdgcn_readfirstlane(ulist[it]); };
        sel_run(nun, kbs, qf, kb_, vb_, tqs, qq, o, m, l, g);
#pragma unroll
        for (int s_ = 0; s_ < 2; ++s_) {
            float ls = l[s_]; ls += shx(ls, 16); ls += shx(ls, 32);
            const float gs = (float)P[(rowb + tqs[s_]) * NPROJ + 38 * 64 + h * 3 + 1] / fmaxf(ls, 1e-30f);
#pragma unroll
            for (int dt = 0; dt < 4; ++dt)
#pragma unroll
                for (int r = 0; r < 4; ++r) outT[((4 * s_ + qq) * 4 + h) * 64 + 16 * dt + 4 * g + r] += gs * o[s_][dt][r];
        }
        LDS_WAIT(); __builtin_amdgcn_wave_barrier();
    }
    {
        const int q8 = c & 7, tq = t0 + q8;
        half8 qf[2][2];
#pragma unroll
        for (int s_ = 0; s_ < 2; ++s_) { const half_t* qrow = P + (rowb + tq) * NPROJ + (2 * s_ + (c >> 3)) * 64; qf[s_][0] = *(const half8*)(qrow + 8 * g); qf[s_][1] = *(const half8*)(qrow + 32 + 8 * g); }
        const half_t* kb_ = X.kf + (size_t)(1 * 2 + b) * 64 * S + loff;
        const half_t* vb_ = X.vt + (size_t)(1 * 2 + b) * 64 * S + loff;
        auto valid = [&](int, int key) { return key <= tq && tq - key <= 511; };
        float m[2] = {-1e30f, -1e30f}, l[2] = {0.f, 0.f}; f32x4 o[2][4];
#pragma unroll
        for (int s_ = 0; s_ < 2; ++s_)
#pragma unroll
            for (int dt = 0; dt < 4; ++dt) o[s_][dt] = (f32x4){0.f, 0.f, 0.f, 0.f};
        const int lo_ = t0 - 511; const int kb0 = (lo_ > 0 ? lo_ : 0) & ~31;
        auto kbw = [&](int it) { return kb0 + 64 * it; };
        attn_runN<2, 0>(((((t0 + 7) >> 5) - (kb0 >> 5)) >> 1) + 1, kbw, S / 32 - 1, qf, kb_, vb_, valid, o, m, l, g);
#pragma unroll
        for (int s_ = 0; s_ < 2; ++s_) {
            const int h = 2 * s_ + (c >> 3);
            float ls = l[s_]; ls += shx(ls, 16); ls += shx(ls, 32);
            const float gwv = (float)P[(rowb + tq) * NPROJ + 38 * 64 + h * 3 + 2] / ls;
#pragma unroll
            for (int dt = 0; dt < 4; ++dt)
#pragma unroll
                for (int r = 0; r < 4; ++r) outT[(q8 * 4 + h) * 64 + 16 * dt + 4 * g + r] += gwv * o[s_][dt][r];
        }
        LDS_WAIT(); __builtin_amdgcn_wave_barrier();
    }
#pragma unroll
    for (int q = 0; q < 8; ++q) {
        const f32x4 v = *(const f32x4*)(outT + q * 256 + 4 * lane);
        u32x2 pk; pk.x = pg8::pkh(v[0], v[1]); pk.y = pg8::pkh(v[2], v[3]);
        *(u32x2*)(X.mix + (rowb + t0 + q) * D + 4 * lane) = pk;
    }
    LDS_WAIT(); __builtin_amdgcn_wave_barrier();
}

__device__ __forceinline__ void b_unit(const ACtx& X, int b, int h6, int fb, int lane) {
    const int c = lane & 15, g = lane >> 4;
    const int sh = 2 * (h6 >> 1), dil = 1 << sh, n = S >> sh, bpc = n >> 5;
    const int r = fb / bpc, i0 = (fb % bpc) * 32;
    const size_t rowb = (size_t)b * S;
    const half_t* P = X.proj;
    half8 qf[2][2]; int iqs[2], tls[2];
#pragma unroll
    for (int s_ = 0; s_ < 2; ++s_) { iqs[s_] = i0 + 16 * s_ + c; tls[s_] = iqs[s_] * dil + r; const half_t* qrow = P + (rowb + tls[s_]) * NPROJ + (10 + h6) * 64; qf[s_][0] = *(const half8*)(qrow + 8 * g); qf[s_][1] = *(const half8*)(qrow + 32 + 8 * g); }
    const int loff = (c * 4 + g) * 8;
    const half_t* kb_ = X.kf + (size_t)((2 + h6) * 2 + b) * 64 * S + (size_t)r * n * 64 + loff;
    const half_t* vb_ = X.vt + (size_t)((2 + h6) * 2 + b) * 64 * S + (size_t)r * n * 64 + loff;
    auto valid = [&](int s_, int kf) { return kf <= iqs[s_] && iqs[s_] - kf <= 128; };
    float m[2] = {-1e30f, -1e30f}, l[2] = {0.f, 0.f}; f32x4 o[2][4];
#pragma unroll
    for (int s_ = 0; s_ < 2; ++s_)
#pragma unroll
        for (int dt = 0; dt < 4; ++dt) o[s_][dt] = (f32x4){0.f, 0.f, 0.f, 0.f};
    const int lo_ = i0 - 128; const int kb0 = (lo_ > 0 ? lo_ : 0) & ~31;
    auto kbw = [&](int it) { return kb0 + 64 * it; };
    attn_runN<2, 0>(((((i0 + 31) >> 5) - (kb0 >> 5)) >> 1) + 1, kbw, (n >> 5) - 1, qf, kb_, vb_, valid, o, m, l, g);
#pragma unroll
    for (int s_ = 0; s_ < 2; ++s_) {
        float ls = l[s_]; ls += shx(ls, 16); ls += shx(ls, 32);
        const float inv = 1.f / ls;
        half_t* op = X.mix + (rowb + tls[s_]) * D + (4 + h6) * 64 + 4 * g;
#pragma unroll
        for (int dt = 0; dt < 4; ++dt) { u32x2 pk; pk.x = pg8::pkh(o[s_][dt][0] * inv, o[s_][dt][1] * inv); pk.y = pg8::pkh(o[s_][dt][2] * inv, o[s_][dt][3] * inv); *(u32x2*)(op + 16 * dt) = pk; }
        if (g == 0) X.lse[(rowb + tls[s_]) * 6 + h6] = m[s_] + __builtin_amdgcn_logf(ls);
    }
}

__device__ __forceinline__ void c_unit(const ACtx& X, int b, int kvh, int qb, int lane) {
    const int c = lane & 15, g = lane >> 4;
    const int t0 = qb * 16, tq = t0 + c;
    const size_t rowb = (size_t)b * S;
    const half_t* P = X.proj;
    half8 qf[3][2]; float m[3], l[3]; f32x4 o[3][4];
#pragma unroll
    for (int s_ = 0; s_ < 3; ++s_) { const half_t* qrow = P + (rowb + tq) * NPROJ + (28 + 3 * kvh + s_) * 64; qf[s_][0] = *(const half8*)(qrow + 8 * g); qf[s_][1] = *(const half8*)(qrow + 32 + 8 * g);
        m[s_] = X.sinks[3 * kvh + s_] * LOG2E; l[s_] = (g == 0) ? 1.f : 0.f;
#pragma unroll
        for (int dt = 0; dt < 4; ++dt) o[s_][dt] = (f32x4){0.f, 0.f, 0.f, 0.f}; }
    const int loff = (c * 4 + g) * 8;
    const half_t* kb_ = X.kf + (size_t)((8 + kvh) * 2 + b) * 64 * S + loff;
    const half_t* vb_ = X.vt + (size_t)((8 + kvh) * 2 + b) * 64 * S + loff;
    auto valid = [&](int, int key) { return key <= tq && tq - key <= 127; };
    const int lo_ = t0 - 127; const int kb0 = (lo_ > 0 ? lo_ : 0) & ~31;
    auto kbw = [&](int it) { return kb0 + 64 * it; };
    attn_runN<3, 0>(((((t0 + 15) >> 5) - (kb0 >> 5)) >> 1) + 1, kbw, S / 32 - 1, qf, kb_, vb_, valid, o, m, l, g);
#pragma unroll
    for (int s_ = 0; s_ < 3; ++s_) {
        float ls = l[s_]; ls += shx(ls, 16); ls += shx(ls, 32);
        const float inv = 1.f / ls;
        half_t* op = X.mix + (rowb + tq) * D + (10 + 3 * kvh + s_) * 64 + 4 * g;
#pragma unroll
        for (int dt = 0; dt < 4; ++dt) { u32x2 pk; pk.x = pg8::pkh(o[s_][dt][0] * inv, o[s_][dt][1] * inv); pk.y = pg8::pkh(o[s_][dt][2] * inv, o[s_][dt][3] * inv); *(u32x2*)(op + 16 * dt) = pk; }
    }
}

__device__ __forceinline__ float gelu_tanh(float v) {
    const float z = 0.7978845608028654f * (v + 0.044715f * v * v * v);
    const float t = __expf(2.f * z);
    const float th = 1.f - 2.f / (t + 1.f);
    return 0.5f * v * (1.f + th);
}

#ifndef PH
#define PH 0xFFFF
#endif
#ifndef REP
#define REP 0
#endif
typedef const Args __attribute__((address_space(4)))* ArgsP;
__device__ __forceinline__ ArgsP largs() { auto p = __builtin_amdgcn_kernarg_segment_ptr(); asm volatile("" : "+s"(p)); return (ArgsP)p; }
struct Ids { int tid, lane, wave, G, NW, gw, gtid, NT; };
__device__ __forceinline__ Ids make_ids() {
    Ids I; int t = threadIdx.x; asm volatile("" : "+v"(t));
    int bid = blockIdx.x; asm volatile("" : "+s"(bid));
    I.tid = t; I.lane = t & 63; I.wave = __builtin_amdgcn_readfirstlane(t >> 6); I.G = gridDim.x; I.NW = I.G * NWAVES; I.gw = bid * NWAVES + I.wave;
    I.gtid = bid * NTHREADS + t; I.NT = I.G * NTHREADS; return I;
}
__device__ __forceinline__ int opaque_bid() { int bid = blockIdx.x; asm volatile("" : "+s"(bid)); return bid; }
__device__ __forceinline__ unsigned char* ws_base(ArgsP a) {
    const unsigned long long v = (unsigned long long)a->ws;
    unsigned lo = __builtin_amdgcn_readfirstlane((unsigned)v), hi = __builtin_amdgcn_readfirstlane((unsigned)(v >> 32));
    asm volatile("" : "+s"(lo), "+s"(hi));
    return (unsigned char*)(((unsigned long long)hi << 32) | lo);
}

__device__ __forceinline__ void phase_p0a(ArgsP a, unsigned char* lds) {
    const Ids I = make_ids(); unsigned char* ws = ws_base(a);
    const int tid = I.tid, lane = I.lane, wave = I.wave, G = I.G;
    half_t* wt_in = (half_t*)(ws + WS_WT_IN); half_t* wt_out = (half_t*)(ws + WS_WT_OUT); half_t* wt_dn = (half_t*)(ws + WS_WT_DN);
    float* cosT = (float*)(ws + WS_COS); float* sinT = (float*)(ws + WS_SIN); float* ada = (float*)(ws + WS_ADA);
    float* red = (float*)(lds + 80 * 1024);
    for (int item = opaque_bid(); item < DEPTH * 96; item += G) {
        const int l = item / 96, jc = item % 96, jl = tid & 63, j = jc * 64 + jl, kg = tid >> 6;
        float a0 = 0.f, a1 = 0.f;
        for (int k0 = kg * 128; k0 < kg * 128 + 128; k0 += 16) {
            float w[16];
#pragma unroll
            for (int u = 0; u < 16; ++u) w[u] = a->w_ada[((size_t)l * D + k0 + u) * 6144 + j];
#pragma unroll
            for (int u = 0; u < 16; ++u) { const float c0 = a->c[k0 + u], c1 = a->c[D + k0 + u]; a0 += (c0 / (1.f + __expf(-c0))) * w[u]; a1 += (c1 / (1.f + __expf(-c1))) * w[u]; }
        }
        red[(kg * 64 + jl) * 2 + 0] = a0; red[(kg * 64 + jl) * 2 + 1] = a1;
        __syncthreads();
        if (tid < 128) { const int jj = tid & 63, bb = tid >> 6; float s = 0.f;
#pragma unroll
            for (int q = 0; q < 8; ++q) s += red[(q * 64 + jj) * 2 + bb];
            ada[((size_t)l * 2 + bb) * 6144 + jc * 64 + jj] = s + a->b_ada[(size_t)l * 6144 + jc * 64 + jj]; }
        __syncthreads();
    }
    float* scr = (float*)lds + wave * (64 * 33);
    constexpr int I_IN = 16 * (NPROJ / 32), I_OUT = 16 * (D / 32), I_DN = (DFF / 64) * (D / 32);
    constexpr int NITEMS = DEPTH * (I_IN + I_OUT + I_DN);
    for (int it = I.gw; it < NITEMS; it += I.NW) {
        int r = it;
        if (r < DEPTH * I_IN) { const int l = r / I_IN; r %= I_IN; transpose_item(a->w_in + (size_t)l * D * NIN, NIN, D, wt_in + (size_t)l * NPROJ * D, NPROJ / 32, scr, r, lane, [](int p) { return win_src_col(p); }); continue; }
        r -= DEPTH * I_IN;
        if (r < DEPTH * I_OUT) { const int l = r / I_OUT; r %= I_OUT; transpose_item(a->w_out + (size_t)l * D * D, D, D, wt_out + (size_t)l * D * D, D / 32, scr, r, lane, [](int p) { return p; }); continue; }
        r -= DEPTH * I_OUT;
        { const int l = r / I_DN; r %= I_DN; transpose_item(a->w_down + (size_t)l * DFF * D, D, DFF, wt_dn + (size_t)l * D * DFF, D / 32, scr, r, lane, [](int p) { return p; }); }
    }
    {
        half_t* cw = (half_t*)(ws + WS_CW); float* cbias = (float*)(ws + WS_CB);
        for (int it = I.gw; it < DEPTH * 2 * 64; it += I.NW) {
            const int l = it >> 7, kv = (it >> 6) & 1, r = it & 63;
            if (kv == 0) transpose_item<true>(a->cmp_w_k + (size_t)l * 2048 * 64, 64, 2048, cw + (size_t)(l * 2 + 0) * 64 * 2048, 2, scr, r, lane, [](int p) { return rope_perm(p); });
            else transpose_item<false>(a->cmp_w_v + (size_t)l * 2048 * 64, 64, 2048, cw + (size_t)(l * 2 + 1) * 64 * 2048, 2, scr, r, lane, [](int p) { return p; });
        }
        for (int it = I.gw; it < DEPTH * 2; it += I.NW) {
            const int l = it >> 1, kv = it & 1;
            const float* w = (kv == 0 ? a->cmp_w_k : a->cmp_w_v) + (size_t)l * 2048 * 64; const float* pe = (kv == 0 ? a->cmp_pe_k : a->cmp_pe_v) + (size_t)l * 2048;
            const int e = kv == 0 ? rope_perm(lane) : lane; float acc = 0.f;
            for (int k = 0; k < 2048; ++k) acc += pe[k] * w[(size_t)k * 64 + e];
            cbias[(l * 2 + kv) * 64 + lane] = acc;
        }
    }
    for (int idx = I.gtid; idx < M * 32; idx += I.NT) {
        const int mrow = idx >> 5, i = idx & 31;
        const float ang = (float)a->positions[mrow] * a->inv_freq[i];
        const double xd = (double)ang; const double kq = rint(xd * 0.15915494309189535);
        const float rf = (float)fma(-kq, 6.283185307179586, xd);
        cosT[idx] = cosf(rf); sinT[idx] = sinf(rf);
    }
}

__device__ __forceinline__ void phase_p0b(ArgsP a) {
    const Ids I = make_ids(); unsigned char* ws = ws_base(a);
    const float* ada = (const float*)(ws + WS_ADA); half_t* hx = (half_t*)(ws + WS_HX);
    rowwise_phase<false, true, 0, 0>(a->x, nullptr, nullptr, nullptr, nullptr, nullptr, a->norm_w + 0 * D, ada + 1024, ada + 0, hx, I.gw, I.NW, I.lane);
}

__device__ __forceinline__ void phase_inproj(ArgsP a, int layer, unsigned char* lds) {
    unsigned char* ws = ws_base(a);
    pg8::Gemm g{(const half_t*)(ws + WS_HX), (const half_t*)(ws + WS_WT_IN) + (size_t)layer * NPROJ * D, M, NPROJ, D, D};
    pg8::StaticOrder So; So.init(M, NPROJ, (int)gridDim.x, opaque_bid());
    pg8::EpiProj E{(half_t*)(ws + WS_PROJ), (const float*)(ws + WS_COS), (const float*)(ws + WS_SIN), (half_t*)(ws + WS_VT), (half_t*)(ws + WS_KF), ws + WS_KS8, ws + WS_VS8};
    pg8::gemm_phase<pg8::EpiProj>((PG8_LAS unsigned char*)lds, g, So, E);
}

__device__ __forceinline__ void phase_compress(ArgsP a, int layer, unsigned char* lds) {
    const Ids I = make_ids(); unsigned char* ws = ws_base(a);
    const int lane = I.lane;
    const half_t* proj = (const half_t*)(ws + WS_PROJ); half_t* kc = (half_t*)(ws + WS_KC); half_t* vct = (half_t*)(ws + WS_VCT); half_t* wt_gu = (half_t*)(ws + WS_WT_GU);
    {
        const half_t* cw = (const half_t*)(ws + WS_CW) + (size_t)layer * 2 * 64 * 2048; const float* cbias = (const float*)(ws + WS_CB) + layer * 128;
        const int c = lane & 15, g = lane >> 4;
        for (int wu = I.gw - (I.NW - 1024); wu >= 0 && wu < 1024; wu += I.NW) {
            const int kv = wu >> 9, b = (wu >> 8) & 1, nb = (wu >> 2) & 63, et = wu & 3;
            const int nrow = 16 * nb + c;
            const half_t* wrow = cw + ((size_t)kv * 64 + 16 * et + c) * 2048 + 8 * g;
            const half_t* xcol = proj + (size_t)b * S * NPROJ + (4 + kv) * 64 + 8 * g;
            f32x4 acc = {0.f, 0.f, 0.f, 0.f};
#pragma unroll 1
            for (int k8 = 0; k8 < 64; k8 += 8) {
                half8 af[8], bf[8];
#pragma unroll
                for (int u = 0; u < 8; ++u) { const int ks = k8 + u; int tok = 16 * nrow + (ks >> 1); tok = tok < S ? tok : S - 1;
                    af[u] = *(const half8*)(xcol + (size_t)tok * NPROJ + 32 * (ks & 1)); bf[u] = *(const half8*)(wrow + 32 * ks); }
#pragma unroll
                for (int u = 0; u < 8; ++u) acc = MFMA16(af[u], bf[u], acc);
            }
            const float bs = cbias[kv * 64 + 16 * et + c];
#pragma unroll
            for (int r = 0; r < 4; ++r) {
                const int n = 16 * nb + 4 * g + r, e = 16 * et + c;
                const float v = (n == 1023) ? 0.f : acc[r] + bs;
                if (kv == 0) kc[(size_t)b * 65536 + (size_t)(n >> 5) * 2048 + ((((n >> 4) & 1) * 2 + (e >> 5)) * 64 + (n & 15) * 4 + ((e >> 3) & 3)) * 8 + (e & 7)] = (half_t)v;
                else vct[(size_t)b * 65536 + (size_t)(n >> 5) * 2048 + (e * 4 + ((n & 15) >> 2)) * 8 + (n & 3) + 4 * ((n >> 4) & 1)] = (half_t)v;
            }
        }
    }
    float* scr = (float*)lds + I.wave * (64 * 33);
    constexpr int I_G = 16 * (DFF / 32);
    const float* wg = a->w_gate + (size_t)layer * D * DFF; const float* wu_ = a->w_up + (size_t)layer * D * DFF;
    for (int it = I.gw; it < 2 * I_G; it += I.NW) {
        const int up = it >= I_G, r = up ? it - I_G : it, n0 = 32 * (r % (DFF / 32));
        const long dsh = (long)(256 * (n0 >> 7) + (n0 & 127) + 128 * up) - n0;
        transpose_item(up ? wu_ : wg, DFF, D, wt_gu + dsh * D, DFF / 32, scr, r, lane, [](int p) { return p; });
    }
}

__device__ __forceinline__ void phase_attn(ArgsP a, int layer, unsigned char* lds) {
    const Ids I = make_ids(); unsigned char* ws = ws_base(a);
    ACtx X{(const half_t*)(ws + WS_PROJ), (const half_t*)(ws + WS_KC), (const half_t*)(ws + WS_VCT), (const half_t*)(ws + WS_VT), (const half_t*)(ws + WS_KF), (half_t*)(ws + WS_MIX), (float*)(ws + WS_LSE), a->sinks + layer * 6, ws + WS_KS8, ws + WS_VS8};
    float* ldsw = (float*)lds + I.wave * 4288;
    for (int i = 0; i < 2; ++i) {
        const int ua = (i == 0) ? I.gw : (4095 - I.gw);
        if (ua >= 0 && ua < 4096) a_unit(X, ua >> 11, (ua & 2047) * 8, ldsw, I.lane);
    }
    if (I.G == 256) {
        const int bid = I.gw >> 3;
        int start = 0;
        for (int b2 = 0; b2 < bid; ++b2) { const int e2 = 2 * b2 - 255; start += 8 * (2 + (((e2 < 0 ? -e2 : e2) * 3 + 64) >> 7)); }
        const int e1 = 2 * bid - 255; const int n = 2 + (((e1 < 0 ? -e1 : e1) * 3 + 64) >> 7);
        start += (I.gw & 7) * n;
        for (int k = start; k < start + n; ++k) {
            if (k < 6144) { const int b = k / 3072, rem = k % 3072; b_unit(X, b, rem >> 9, rem & 511, I.lane); }
            else { const int u = k - 6144; const int b = u >> 11, rem = u & 2047; c_unit(X, b, rem >> 10, rem & 1023, I.lane); }
        }
    } else {
        for (int u = I.gw; u < 6144; u += I.NW) { const int b = u / 3072, rem = u % 3072; b_unit(X, b, rem >> 9, rem & 511, I.lane); }
        for (int u = I.gw; u < 4096; u += I.NW) { const int b = u >> 11, rem = u & 2047; c_unit(X, b, rem >> 10, rem & 1023, I.lane); }
    }
}

__device__ __forceinline__ void phase_combine(ArgsP a) {
    const Ids I = make_ids(); unsigned char* ws = ws_base(a);
    const float* lse = (const float*)(ws + WS_LSE); half_t* mix = (half_t*)(ws + WS_MIX);
    for (int idx0 = I.gtid; idx0 < M * 48; idx0 += 4 * I.NT) {
        float l0[4], l1[4], l2[4]; half8 v[4]; bool ok[4];
#pragma unroll
        for (int u = 0; u < 4; ++u) {
            const int idx = idx0 + u * I.NT; ok[u] = idx < M * 48;
            const int ix = ok[u] ? idx : idx0;
            const int c8 = ix & 7, h6 = (ix >> 3) % 6, mrow = ix / 48, hh = h6 & 1;
            l0[u] = lse[(size_t)mrow * 6 + hh]; l1[u] = lse[(size_t)mrow * 6 + 2 + hh]; l2[u] = lse[(size_t)mrow * 6 + 4 + hh];
            v[u] = *(const half8*)(mix + (size_t)mrow * D + (4 + h6) * 64 + c8 * 8);
        }
#pragma unroll
        for (int u = 0; u < 4; ++u) {
            const int idx = idx0 + u * I.NT;
            if (!ok[u]) continue;
            const int c8 = idx & 7, h6 = (idx >> 3) % 6, mrow = idx / 48, gsel = h6 >> 1;
            const float mx = fmaxf(l0[u], fmaxf(l1[u], l2[u]));
            const float e0 = __builtin_amdgcn_exp2f(l0[u] - mx), e1 = __builtin_amdgcn_exp2f(l1[u] - mx), e2 = __builtin_amdgcn_exp2f(l2[u] - mx);
            const float al = (gsel == 0 ? e0 : (gsel == 1 ? e1 : e2)) / (e0 + e1 + e2);
            half8 w = v[u];
#pragma unroll
            for (int j = 0; j < 8; ++j) w[j] = (half_t)((float)w[j] * al);
            *(half8*)(mix + (size_t)mrow * D + (4 + h6) * 64 + c8 * 8) = w;
        }
    }
}

__device__ __forceinline__ void phase_outproj(ArgsP a, int layer, unsigned char* lds) {
    unsigned char* ws = ws_base(a);
    pg8::Gemm g{(const half_t*)(ws + WS_MIX), (const half_t*)(ws + WS_WT_OUT) + (size_t)layer * D * D, M, D, D, D};
    pg8::StaticOrder So; So.init(M, D, (int)gridDim.x, opaque_bid());
    pg8::EpiF16 E{(half_t*)(ws + WS_HX), D};
    pg8::gemm_phase<pg8::EpiF16>((PG8_LAS unsigned char*)lds, g, So, E);
}

__device__ __forceinline__ void phase_r1(ArgsP a, int layer) {
    const Ids I = make_ids(); unsigned char* ws = ws_base(a);
    const float* adaL = (const float*)(ws + WS_ADA) + (size_t)layer * 2 * 6144; const float* nw = a->norm_w + (size_t)layer * 4 * D; half_t* hx = (half_t*)(ws + WS_HX);
    half_t* x16 = (half_t*)(ws + WS_X16);
    if (layer == 0) rowwise_phase<true, true, 0, 1>(a->x, x16, nullptr, hx, nw + 1 * D, adaL + 2048, nw + 2 * D, adaL + 4096, adaL + 3072, hx, I.gw, I.NW, I.lane);
    else rowwise_phase<true, true, 1, 1>(nullptr, x16, nullptr, hx, nw + 1 * D, adaL + 2048, nw + 2 * D, adaL + 4096, adaL + 3072, hx, I.gw, I.NW, I.lane);
}

__device__ __forceinline__ void phase_gateup(ArgsP a, int layer, unsigned char* lds) {
    unsigned char* ws = ws_base(a);
    pg8::Gemm g{(const half_t*)(ws + WS_HX), (const half_t*)(ws + WS_WT_GU), M, NGU, D, D};
    pg8::StaticOrder So; So.init(M, NGU, (int)gridDim.x, opaque_bid());
    pg8::EpiAct E{(half_t*)(ws + WS_ACT), a->conv_w + (size_t)layer * 3 * DFF, a->conv_b + (size_t)layer * DFF, (float*)(ws + WS_GB), (float*)(ws + WS_UB)};
    pg8::gemm_phase<pg8::EpiAct>((PG8_LAS unsigned char*)lds, g, So, E);
}

__device__ __forceinline__ void phase_act(ArgsP a, int layer) {
    const Ids I = make_ids(); unsigned char* ws = ws_base(a);
    half_t* act = (half_t*)(ws + WS_ACT); const float* gb = (const float*)(ws + WS_GB); const float* ub = (const float*)(ws + WS_UB);
    const float* cw = a->conv_w + (size_t)layer * 3 * DFF; const float* cb = a->conv_b + (size_t)layer * DFF;
    for (int idx0 = I.gtid; idx0 < 128 * 2 * DFF; idx0 += 4 * I.NT) {
        float g0[4], uu[4], gm1[4], gm2[4], gr0[4], c0[4], c1[4], c2[4], cbv[4]; bool ok[4];
#pragma unroll
        for (int u = 0; u < 4; ++u) {
            const int idx = idx0 + u * I.NT; ok[u] = idx < 128 * 2 * DFF;
            const int ix = ok[u] ? idx : idx0;
            const int pm = ix / (2 * DFF), rem = ix % (2 * DFF), row = rem / DFF, j = rem % DFF;
            g0[u] = gb[((size_t)pm * 4 + row) * DFF + j]; uu[u] = ub[((size_t)pm * 2 + row) * DFF + j];
            gm1[u] = 0.f; gm2[u] = 0.f;
            if ((pm & 63) != 0) { gm1[u] = gb[((size_t)(pm - 1) * 4 + 3) * DFF + j]; gm2[u] = gb[((size_t)(pm - 1) * 4 + 2) * DFF + j]; }
            gr0[u] = gb[((size_t)pm * 4 + 0) * DFF + j];
            c0[u] = cw[j]; c1[u] = cw[DFF + j]; c2[u] = cw[2 * DFF + j]; cbv[u] = cb[j];
        }
#pragma unroll
        for (int u = 0; u < 4; ++u) {
            const int idx = idx0 + u * I.NT;
            if (!ok[u]) continue;
            const int pm = idx / (2 * DFF), rem = idx % (2 * DFF), row = rem / DFF, j = rem % DFF;
            const float g1 = row == 0 ? gm1[u] : gr0[u], g2 = row == 0 ? gm2[u] : gm1[u];
            const float v = c0[u] * g2 + c1[u] * g1 + c2[u] * g0[u] + cbv[u];
            act[((size_t)pm * 256 + row) * DFF + j] = (half_t)(gelu_tanh(v) * uu[u]);
        }
    }
}

__device__ __forceinline__ void phase_down(ArgsP a, int layer, unsigned char* lds) {
    unsigned char* ws = ws_base(a);
    pg8::Gemm g{(const half_t*)(ws + WS_ACT), (const half_t*)(ws + WS_WT_DN) + (size_t)layer * D * DFF, M, D, DFF, DFF};
    pg8::StaticOrder So; So.init(M, D, (int)gridDim.x, opaque_bid());
    pg8::EpiF16 E{(half_t*)(ws + WS_HX), D};
    pg8::gemm_phase<pg8::EpiF16>((PG8_LAS unsigned char*)lds, g, So, E);
}

__device__ __forceinline__ void phase_r2(ArgsP a, int layer) {
    const Ids I = make_ids(); unsigned char* ws = ws_base(a);
    const float* ada = (const float*)(ws + WS_ADA); const float* adaL = ada + (size_t)layer * 2 * 6144; const float* nw = a->norm_w + (size_t)layer * 4 * D; half_t* hx = (half_t*)(ws + WS_HX);
    if (layer + 1 < DEPTH) {
        const float* adaN = ada + (size_t)(layer + 1) * 2 * 6144;
        rowwise_phase<true, true, 1, 1>(nullptr, (half_t*)(ws + WS_X16), nullptr, hx, nw + 3 * D, adaL + 5120, a->norm_w + (size_t)(layer + 1) * 4 * D, adaN + 1024, adaN + 0, hx, I.gw, I.NW, I.lane);
    } else {
        rowwise_phase<true, false, 1, 2>(nullptr, (half_t*)(ws + WS_X16), a->out, hx, nw + 3 * D, adaL + 5120, nullptr, nullptr, nullptr, nullptr, I.gw, I.NW, I.lane);
    }
}

#define LAS __attribute__((address_space(3)))
#define XB_TMO      128
#define XB_XCNT(j)  (256  + 64 * (j))
#define XB_XSUB(j)  (1280 + 64 * (j))
#define XB_XGEN(j)  (2304 + 64 * (j))
#define XB_TOP      3328
#define XB_TOPGEN   3392
#define XCD_BAR_WORDS 3456
#define XB_SPIN_CAP (1u << 22)
__device__ __forceinline__ unsigned xb_ld(unsigned* p)              { return __hip_atomic_load(p, __ATOMIC_RELAXED, __HIP_MEMORY_SCOPE_AGENT); }
__device__ __forceinline__ unsigned xb_add(unsigned* p, unsigned v) { return __hip_atomic_fetch_add(p, v, __ATOMIC_RELAXED, __HIP_MEMORY_SCOPE_AGENT); }
__device__ __forceinline__ unsigned xb_xcc_id() { return (unsigned)__builtin_amdgcn_s_getreg((3 << 11) | 20) & 0xFu; }
#define XB_SPIN(cond, bar) do { unsigned _sp = 0; while (cond) { __builtin_amdgcn_s_sleep(1); \
    if ((++_sp & 255u) == 0u) { if (xb_ld(&(bar)[XB_TMO])) break; if (_sp > XB_SPIN_CAP) { atomicAdd(&(bar)[XB_TMO], 1u); break; } } } } while (0)
__device__ __forceinline__ void xcd_barrier_complete(unsigned* bar, unsigned x, unsigned& nloc, unsigned& nx) {
    const unsigned G = gridDim.x * gridDim.y * gridDim.z;
    unsigned sum, cnt, mine, sp = 0u;
    for (;;) {
        sum = 0u; cnt = 0u; mine = 0u;
#pragma unroll
        for (unsigned j = 0; j < 16; ++j) { const unsigned c = xb_ld(&bar[XB_XCNT(j)]); sum += c; cnt += (c > 0u) ? 1u : 0u; mine = (j == x) ? c : mine; }
        if (sum == G) break;
        __builtin_amdgcn_s_sleep(1);
        if ((++sp & 255u) == 0u) { if (xb_ld(&bar[XB_TMO])) break; if (sp > XB_SPIN_CAP) { atomicAdd(&bar[XB_TMO], 1u); break; } }
    }
    nloc = mine > 0u ? mine : 1u; nx = cnt > 0u ? cnt : 1u;
}
__device__ __forceinline__ void xcd_barrier(unsigned* bar, volatile LAS unsigned* st) {
    asm volatile("s_waitcnt vmcnt(0)" ::: "memory");
    __syncthreads();
    if (threadIdx.x == 0) {
        const unsigned x = xb_xcc_id();
        __builtin_amdgcn_s_waitcnt(0);
        unsigned nloc = st[0], nx = st[1];
        if (nloc == 0u) { xcd_barrier_complete(bar, x, nloc, nx); st[0] = nloc; st[1] = nx; }
        const unsigned old = xb_add(&bar[XB_XSUB(x)], 1u);
        const unsigned gen = old / nloc;
        if (old + 1u == (gen + 1u) * nloc) {
            __builtin_amdgcn_fence(__ATOMIC_RELEASE, "agent");
            asm volatile("s_waitcnt vmcnt(0)" ::: "memory");
            const unsigned og = xb_add(&bar[XB_TOP], 1u);
            const unsigned tg = og / nx;
            if (og + 1u == (tg + 1u) * nx) xb_add(&bar[XB_TOPGEN], 1u);
            else XB_SPIN(xb_ld(&bar[XB_TOPGEN]) == tg, bar);
            __builtin_amdgcn_fence(__ATOMIC_ACQUIRE, "agent");
            xb_add(&bar[XB_XGEN(x)], 1u);
            asm volatile("s_waitcnt vmcnt(0)" ::: "memory");
        } else {
            XB_SPIN(xb_ld(&bar[XB_XGEN(x)]) == gen, bar);
            __builtin_amdgcn_fence(__ATOMIC_ACQUIRE, "agent");
            asm volatile("s_waitcnt vmcnt(0)" ::: "memory");
        }
    }
    __syncthreads();
}

__global__ void __launch_bounds__(NTHREADS, 2) trunk_fwd(Args a) {
    extern __shared__ __attribute__((aligned(16))) unsigned char lds[];
    cg::grid_group grid = cg::this_grid();
    volatile LAS unsigned* bst = (volatile LAS unsigned*)((LAS unsigned char*)lds + (LDS_BYTES - 64));
    if (threadIdx.x < 2) bst[threadIdx.x] = 0u;
    if (blockIdx.x == 0) { unsigned* bw = (unsigned*)(a.ws + WS_BAR); for (int i = threadIdx.x; i < XCD_BAR_WORDS; i += NTHREADS) bw[i] = 0u; }
    if (PH & 1) phase_p0a(largs(), lds);
    if (REP & 1) { phase_p0a(largs(), lds); }
    grid.sync();
    if (threadIdx.x == 0) (void)xb_add((unsigned*)(largs()->ws + WS_BAR) + XB_XCNT(xb_xcc_id()), 1u);
#define GSYNC() xcd_barrier((unsigned*)(largs()->ws + WS_BAR), bst)
    if (PH & 2) phase_p0b(largs());
    GSYNC();
    for (int layer = 0; layer < DEPTH; ++layer) {
        if (PH & 4) phase_inproj(largs(), layer, lds);
        GSYNC();
        if (REP & 4) { phase_inproj(largs(), layer, lds); GSYNC(); }
        if (PH & 8) phase_compress(largs(), layer, lds);
        GSYNC();
        if (REP & 8) { phase_compress(largs(), layer, lds); GSYNC(); }
        if (PH & 16) phase_attn(largs(), layer, lds);
        GSYNC();
        if (REP & 16) { phase_attn(largs(), layer, lds); GSYNC(); }
        if (PH & 32) phase_combine(largs());
        GSYNC();
        if (PH & 64) phase_outproj(largs(), layer, lds);
        GSYNC();
        if (REP & 64) { phase_outproj(largs(), layer, lds); GSYNC(); }
        if (PH & 128) phase_r1(largs(), layer);
        GSYNC();
        if (PH & 256) phase_gateup(largs(), layer, lds);
        GSYNC();
        if (REP & 256) { phase_gateup(largs(), layer, lds); GSYNC(); }
        if (PH & 512) phase_act(largs(), layer);
        GSYNC();
        if (PH & 1024) phase_down(largs(), layer, lds);
        GSYNC();
        if (REP & 1024) { phase_down(largs(), layer, lds); GSYNC(); }
        if (PH & 2048) phase_r2(largs(), layer);
        if (layer + 1 < DEPTH) GSYNC();
    }
}

extern "C" void kernel_launch(void* const* d_in, const int* in_sizes, int n_in, void* d_out, int out_size, void* d_ws, size_t ws_size, hipStream_t stream) {
    static int grid = 0;
    if (grid == 0) {
        int dev = 0, cus = 0, per_cu = 0;
        if (n_in != 18 || ws_size < WS_END) { fprintf(stderr, "kernel_launch: unexpected inputs (n_in %d, ws %zu)\n", n_in, ws_size); grid = -1; return; }
        hipGetDevice(&dev);
        hipDeviceGetAttribute(&cus, hipDeviceAttributeMultiprocessorCount, dev);
        hipFuncSetAttribute((const void*)trunk_fwd, hipFuncAttributeMaxDynamicSharedMemorySize, LDS_BYTES);
        hipOccupancyMaxActiveBlocksPerMultiprocessor(&per_cu, (const void*)trunk_fwd, NTHREADS, LDS_BYTES);
        if (per_cu < 1) per_cu = 1;
        grid = cus * per_cu;
        (void)hipGetLastError();
    }
    if (grid < 0) return;
    Args a{};
    a.x = (const float*)d_in[0]; a.c = (const float*)d_in[1]; a.positions = (const int*)d_in[2]; a.w_in = (const float*)d_in[3]; a.w_out = (const float*)d_in[4];
    a.w_ada = (const float*)d_in[5]; a.b_ada = (const float*)d_in[6]; a.norm_w = (const float*)d_in[7]; a.cmp_w_k = (const float*)d_in[8]; a.cmp_w_v = (const float*)d_in[9];
    a.cmp_pe_k = (const float*)d_in[10]; a.cmp_pe_v = (const float*)d_in[11]; a.sinks = (const float*)d_in[12]; a.w_gate = (const float*)d_in[13]; a.w_up = (const float*)d_in[14];
    a.conv_w = (const float*)d_in[15]; a.conv_b = (const float*)d_in[16]; a.w_down = (const float*)d_in[17];
    a.out = (float*)d_out; a.ws = (unsigned char*)d_ws;
    for (int i = 0; i < 32; ++i) a.inv_freq[i] = (float)pow(10000.0, -(double)i / 32.0);
    void* args[] = {&a};
    hipError_t e = hipLaunchCooperativeKernel((const void*)trunk_fwd, dim3(grid), dim3(NTHREADS), args, LDS_BYTES, stream);
    if (e != hipSuccess) fprintf(stderr, "cooperative launch failed: %s (grid %d)\n", hipGetErrorString(e), grid);
}
```

```cpp
#include <hip/hip_runtime.h>
#include <hip/hip_cooperative_groups.h>
#include <cstdio>
#include <cstdint>
#include <cmath>
namespace cg = cooperative_groups;

typedef _Float16 half_t;
typedef _Float16 half8 __attribute__((ext_vector_type(8)));
typedef _Float16 half4 __attribute__((ext_vector_type(4)));
typedef _Float16 half2v __attribute__((ext_vector_type(2)));
typedef float f32x4 __attribute__((ext_vector_type(4)));
typedef unsigned u32x4 __attribute__((ext_vector_type(4)));
typedef unsigned u32x2 __attribute__((ext_vector_type(2)));

constexpr int D = 1024, NBATCH = 2, S = 16384, M = NBATCH * S, DEPTH = 4, DFF = 2816;
constexpr int NPROJ = 2560, NIN = 2444, NGU = 2 * DFF;
constexpr float RMS_EPS = 1e-6f;
constexpr float QSCALE = 0.125f * 1.4426950408889634f;
constexpr float LOG2E = 1.4426950408889634f;
constexpr int NWAVES = 8, NTHREADS = 512;

constexpr size_t MiB = 1u << 20;
constexpr size_t WS_WT_IN = 0;
constexpr size_t WS_WT_OUT = 20 * MiB;
constexpr size_t WS_WT_DN = 28 * MiB;
constexpr size_t WS_WT_GU = 50 * MiB;
constexpr size_t WS_COS = 61 * MiB;
constexpr size_t WS_SIN = 65 * MiB;
constexpr size_t WS_ADA = 69 * MiB;
constexpr size_t WS_KC = 70 * MiB;
constexpr size_t WS_VCT = 70 * MiB + 512 * 1024;
constexpr size_t WS_LSE = 71 * MiB;
constexpr size_t WS_HX = 72 * MiB;
constexpr size_t WS_BIG = 136 * MiB;
constexpr size_t WS_PROJ = WS_BIG;
constexpr size_t WS_MIX = WS_BIG + 160 * MiB;
constexpr size_t WS_VT = WS_BIG + 224 * MiB;
constexpr size_t WS_KF = WS_BIG + 264 * MiB;
constexpr size_t WS_ACT = WS_BIG;
constexpr size_t WS_GB = WS_BIG + 176 * MiB;
constexpr size_t WS_UB = WS_BIG + 182 * MiB;
constexpr size_t WS_X16 = 440 * MiB;
constexpr size_t WS_CW = 504 * MiB;
constexpr size_t WS_CB = WS_ADA + 256 * 1024;
constexpr size_t WS_BAR = 506 * MiB;
constexpr size_t WS_KS8 = 507 * MiB;
constexpr size_t WS_VS8 = 509 * MiB;
constexpr size_t WS_END = 511 * MiB;

constexpr int LDS_BYTES = 151552;

namespace pg8 {
#define PG8_LAS __attribute__((address_space(3)))
constexpr int BM = 256, BK = 64, HALF = 128, HTB = HALF * BK * 2, STAGE_BYTES = 8 * HTB, NXCD = 8, WGM = 8;

__host__ __device__ __forceinline__ int lds_byte(int r, int c) { const int st = (r >> 4) * 2 + (c >> 5), rr = r & 15, cc = c & 31, ob = rr * 64 + cc * 2; return st * 1024 + (ob ^ (((ob >> 9) & 1) << 5)); }
__host__ __device__ __forceinline__ void stage_rc(int b, int& R, int& C) { const int st = b / 1024, sb = b % 1024, swz = sb ^ (((sb >> 9) & 1) << 5); R = (st >> 1) * 16 + swz / 64; C = (st & 1) * 32 + (swz % 64) / 2; }
__host__ __device__ __forceinline__ int perm32(int rho) { const int n = rho >> 4, i = rho & 15; return 8 * (i >> 2) + 4 * n + (i & 3); }

struct Unit { int pm, pn; };
struct Gemm { const half_t* A; const half_t* Bt; int M, N, K, lda; };

struct StaticOrder {
    int nM, nN, nwg, G, c;
    __host__ __device__ void init(int M_, int N_, int G_, int c_) { nM = M_ / BM; nN = N_ / BM; nwg = nM * nN; G = G_; c = c_; }
    __host__ __device__ bool next(int i, Unit& u) const {
        const long L = (long)i * G + c; if (L >= nwg) return false;
        int wgid = (int)L; { const int q = nwg / NXCD, r = nwg % NXCD, xcd = wgid % NXCD, off = wgid / NXCD; wgid = (xcd < r ? xcd * (q + 1) : r * (q + 1) + (xcd - r) * q) + off; }
        const int nig = WGM * nN, gid = wgid / nig, fm = gid * WGM, gsz = (nM - fm) < WGM ? (nM - fm) : WGM;
        u.pm = fm + ((wgid % nig) % gsz); u.pn = (wgid % nig) / gsz; return true;
    }
};

__device__ __forceinline__ unsigned pkh(float lo, float hi) { half2v v = {(half_t)lo, (half_t)hi}; return __builtin_bit_cast(unsigned, v); }

struct EpiF16 {
    static constexpr bool PERM = true;
    half_t* O; int ldc;
    __device__ __forceinline__ void operator()(const f32x4 (&acc)[2][2][4][2], const Unit& u, int wr, int wc, int fr, int fq, PG8_LAS unsigned char*) const {
        const int row0 = u.pm * BM + wr * 64 + fr; const int col0 = u.pn * BM + wc * 32 + 8 * fq;
#pragma unroll
        for (int ai = 0; ai < 2; ++ai)
#pragma unroll
            for (int m = 0; m < 4; ++m) { half_t* rowp = O + (size_t)(row0 + ai * HALF + m * 16) * ldc + col0;
#pragma unroll
                for (int bj = 0; bj < 2; ++bj) { const f32x4 v0 = acc[ai][bj][m][0], v1 = acc[ai][bj][m][1];
                    u32x4 w; w.x = pkh(v0[0], v0[1]); w.y = pkh(v0[2], v0[3]); w.z = pkh(v1[0], v1[1]); w.w = pkh(v1[2], v1[3]);
                    *(u32x4*)(rowp + bj * HALF) = w; } }
    }
};

struct EpiProj {
    static constexpr bool PERM = true;
    half_t* P; const float* cosT; const float* sinT; half_t* vt; half_t* kf; unsigned char* ks8; unsigned char* vs8;
    __device__ __forceinline__ void operator()(const f32x4 (&acc)[2][2][4][2], const Unit& u, int wr, int wc, int fr, int fq, PG8_LAS unsigned char* lds) const {
        const int row0 = u.pm * BM + wr * 64 + fr; const int gsub = wc & 1;
        bool isq[2], isk[2], isg[2]; int vi[2], ki[2], col0[2];
#pragma unroll
        for (int bj = 0; bj < 2; ++bj) {
            const int slot = u.pn * 4 + bj * 2 + (wc >> 1);
            isq[bj] = (slot < 4) || (slot >= 10 && slot < 16) || (slot >= 28 && slot < 34);
            isk[bj] = slot == 4 || slot == 6 || slot == 8 || (slot >= 16 && slot < 22) || slot == 34 || slot == 35;
            vi[bj] = -1;
            if (slot == 7) vi[bj] = 0; else if (slot == 9) vi[bj] = 1; else if (slot >= 22 && slot < 28) vi[bj] = 2 + (slot - 22); else if (slot == 36 || slot == 37) vi[bj] = 8 + (slot - 36);
            ki[bj] = -1;
            if (slot == 6) ki[bj] = 0; else if (slot == 8) ki[bj] = 1; else if (slot >= 16 && slot < 22) ki[bj] = 2 + (slot - 16); else if (slot == 34 || slot == 35) ki[bj] = 8 + (slot - 34);
            isg[bj] = slot == 38;
            col0[bj] = slot * 64 + gsub * 32 + 8 * fq;
        }
        const bool anyrope = isq[0] || isk[0] || isq[1] || isk[1];
#pragma unroll
        for (int ai = 0; ai < 2; ++ai)
#pragma unroll
            for (int m = 0; m < 4; ++m) {
                const int row = row0 + ai * HALF + m * 16;
                f32x4 cs = {1.f, 1.f, 1.f, 1.f}, sn = {0.f, 0.f, 0.f, 0.f};
                if (anyrope) { cs = *(const f32x4*)(cosT + (size_t)row * 32 + 16 * gsub + 4 * fq); sn = *(const f32x4*)(sinT + (size_t)row * 32 + 16 * gsub + 4 * fq); }
#pragma unroll
                for (int bj = 0; bj < 2; ++bj) {
                    f32x4 v0 = acc[ai][bj][m][0], v1 = acc[ai][bj][m][1];
                    if (isq[bj] || isk[bj]) {
                        const f32x4 o0 = v0 * cs - v1 * sn, o1 = v1 * cs + v0 * sn;
                        v0 = o0; v1 = o1;
                        if (isq[bj]) { v0 = v0 * QSCALE; v1 = v1 * QSCALE; }
                    } else if (isg[bj]) {
#pragma unroll
                        for (int j = 0; j < 4; ++j) { v0[j] = 1.f / (1.f + __expf(-v0[j])); v1[j] = 1.f / (1.f + __expf(-v1[j])); }
                    }
                    u32x4 w; w.x = pkh(v0[0], v0[1]); w.y = pkh(v0[2], v0[3]); w.z = pkh(v1[0], v1[1]); w.w = pkh(v1[2], v1[3]);
                    if (vi[bj] < 0 && ki[bj] < 0) *(u32x4*)(P + (size_t)row * NPROJ + col0[bj]) = w;
                    else {
                        const int b = row >> 14, tl = row & (S - 1);
                        const int xi = vi[bj] >= 0 ? vi[bj] : ki[bj];
                        int pos = tl;
                        if (xi >= 2 && xi < 8) { const int sh = 2 * ((xi - 2) >> 1); pos = ((tl & ((1 << sh) - 1)) << (14 - sh)) + (tl >> sh); }
                        const size_t blk = ((size_t)(xi * 2 + b) * (S / 32) + (pos >> 5)) * 2048;
                        if (ki[bj] == 0) {
                            u32x2 w8; int p0 = __builtin_amdgcn_cvt_pk_fp8_f32(v0[0], v0[1], 0, false); p0 = __builtin_amdgcn_cvt_pk_fp8_f32(v0[2], v0[3], p0, true);
                            int p1 = __builtin_amdgcn_cvt_pk_fp8_f32(v1[0], v1[1], 0, false); p1 = __builtin_amdgcn_cvt_pk_fp8_f32(v1[2], v1[3], p1, true);
                            w8.x = (unsigned)p0; w8.y = (unsigned)p1;
                            *(u32x2*)(ks8 + ((size_t)b * (S / 32) + (pos >> 5)) * 2048 + ((((pos >> 4) & 1) * 2 + gsub) * 64 + (pos & 15) * 4 + fq) * 8) = w8;
                        } else if (ki[bj] >= 0) {
                            *(u32x4*)(kf + blk + ((((pos >> 4) & 1) * 2 + gsub) * 64 + (pos & 15) * 4 + fq) * 8) = w;
                        } else if (xi == 4 || xi == 5) {
                            half_t* vb = vt + blk + ((gsub * 32 + 8 * fq) * 4 + ((pos & 15) >> 2)) * 8 + (pos & 3) + 4 * ((pos >> 4) & 1);
#pragma unroll
                            for (int j = 0; j < 4; ++j) { vb[j * 32] = (half_t)v0[j]; vb[(4 + j) * 32] = (half_t)v1[j]; }
                        }
                    }
                }
            }
#pragma unroll
        for (int bj = 0; bj < 2; ++bj) {
            const int xi = vi[bj];
            if (xi < 0 || xi == 4 || xi == 5) continue;
            const int lane = fq * 16 + fr, wid = wr * 4 + wc;
            if (xi == 6 || xi == 7) {
#pragma unroll
                for (int ai = 0; ai < 2; ++ai) {
                    const int row = row0 + ai * HALF, b = row >> 14, tl = row & (S - 1);
                    const int p = ((tl & 15) << 10) + (tl >> 4);
                    half_t* vb = vt + ((size_t)(xi * 2 + b) * (S / 32) + (p >> 5)) * 2048 + ((gsub * 32 + 8 * fq) * 4 + ((p & 15) >> 2)) * 8 + 4 * ((p >> 4) & 1);
#pragma unroll
                    for (int j = 0; j < 8; ++j) { u32x2 w; w.x = pkh(acc[ai][bj][0][j >> 2][j & 3], acc[ai][bj][1][j >> 2][j & 3]); w.y = pkh(acc[ai][bj][2][j >> 2][j & 3], acc[ai][bj][3][j >> 2][j & 3]); *(u32x2*)(vb + j * 32) = w; }
                }
            } else {
                PG8_LAS half_t* L = (PG8_LAS half_t*)(lds + STAGE_BYTES) + wid * 1024;
                if (xi == 0) {
                    PG8_LAS unsigned char* L8 = (PG8_LAS unsigned char*)L;
#pragma unroll
                    for (int ai = 0; ai < 2; ++ai)
#pragma unroll
                        for (int mp = 0; mp < 2; ++mp) {
#pragma unroll
                            for (int mm = 0; mm < 2; ++mm)
#pragma unroll
                                for (int j = 0; j < 8; ++j) { const float x = acc[ai][bj][2 * mp + mm][j >> 2][j & 3]; L8[((8 * fq + j) * 4 + (fr >> 2)) * 8 + (fr & 3) + 4 * mm] = (unsigned char)(__builtin_amdgcn_cvt_pk_fp8_f32(x, x, 0, false) & 0xff); }
                            asm volatile("s_waitcnt lgkmcnt(0)" ::: "memory"); __builtin_amdgcn_wave_barrier();
                            const int rowb_ = u.pm * BM + ai * HALF + wr * 64 + 32 * mp, b = rowb_ >> 14, tl = rowb_ & (S - 1);
                            unsigned char* vb = vs8 + ((size_t)b * (S / 32) + (tl >> 5)) * 2048 + (size_t)gsub * 1024;
#pragma unroll
                            for (int t = 0; t < 2; ++t) { const int v = lane + 64 * t; const u32x2 w = *(PG8_LAS u32x2*)(L8 + v * 8); *(u32x2*)(vb + v * 8) = w; }
                            asm volatile("s_waitcnt lgkmcnt(0)" ::: "memory"); __builtin_amdgcn_wave_barrier();
                        }
                    continue;
                }
#pragma unroll
                for (int ai = 0; ai < 2; ++ai)
#pragma unroll
                    for (int mp = 0; mp < 2; ++mp) {
#pragma unroll
                        for (int mm = 0; mm < 2; ++mm)
#pragma unroll
                            for (int j = 0; j < 8; ++j) L[((8 * fq + j) * 4 + (fr >> 2)) * 8 + (fr & 3) + 4 * mm] = (half_t)acc[ai][bj][2 * mp + mm][j >> 2][j & 3];
                        asm volatile("s_waitcnt lgkmcnt(0)" ::: "memory"); __builtin_amdgcn_wave_barrier();
                        const int rowb_ = u.pm * BM + ai * HALF + wr * 64 + 32 * mp, b = rowb_ >> 14, tl = rowb_ & (S - 1);
                        half_t* vb = vt + ((size_t)(xi * 2 + b) * (S / 32) + (tl >> 5)) * 2048 + (size_t)gsub * 1024;
#pragma unroll
                        for (int t = 0; t < 2; ++t) { const int v = lane + 64 * t; const u32x4 w = *(PG8_LAS u32x4*)(L + v * 8); *(u32x4*)(vb + v * 8) = w; }
                        asm volatile("s_waitcnt lgkmcnt(0)" ::: "memory"); __builtin_amdgcn_wave_barrier();
                    }
            }
        }
    }
};

__device__ __forceinline__ float gelu_tanh_f(float v) {
    const float z = 0.7978845608028654f * (v + 0.044715f * v * v * v);
    const float t = __builtin_amdgcn_exp2f(z * 2.8853900817779268f);
    return v * (1.f - __builtin_amdgcn_rcpf(t + 1.f));
}
struct EpiAct {
    static constexpr bool PERM = true;
    half_t* act; const float* cw; const float* cb; float* gb; float* ub;
    __device__ __forceinline__ void operator()(const f32x4 (&acc)[2][2][4][2], const Unit& u, int wr, int wc, int fr, int fq, PG8_LAS unsigned char* lds) const {
        PG8_LAS float* halo = (PG8_LAS float*)(lds + STAGE_BYTES);
        const int lane = fq * 16 + fr;
        const int j0 = u.pn * 128 + wc * 32 + 8 * fq;
#pragma unroll
        for (int ai = 0; ai < 2; ++ai)
            if (fr >= 14) { PG8_LAS float* h = halo + ((((ai * 2 + wr) * 4 + wc) * 2 + (fr - 14)) * 32 + fq * 8);
                *(PG8_LAS f32x4*)h = acc[ai][0][3][0]; *(PG8_LAS f32x4*)(h + 4) = acc[ai][0][3][1]; }
        asm volatile("s_waitcnt lgkmcnt(0)" ::: "memory"); __builtin_amdgcn_s_barrier(); asm volatile("" ::: "memory");
        float w0[8], w1[8], w2[8], bb[8];
        { const f32x4 a0 = *(const f32x4*)(cw + j0), a1 = *(const f32x4*)(cw + j0 + 4), b0 = *(const f32x4*)(cw + DFF + j0), b1 = *(const f32x4*)(cw + DFF + j0 + 4);
          const f32x4 c0 = *(const f32x4*)(cw + 2 * DFF + j0), c1 = *(const f32x4*)(cw + 2 * DFF + j0 + 4), d0 = *(const f32x4*)(cb + j0), d1 = *(const f32x4*)(cb + j0 + 4);
#pragma unroll
          for (int j = 0; j < 4; ++j) { w0[j] = a0[j]; w0[4 + j] = a1[j]; w1[j] = b0[j]; w1[4 + j] = b1[j]; w2[j] = c0[j]; w2[4 + j] = c1[j]; bb[j] = d0[j]; bb[4 + j] = d1[j]; } }
#pragma unroll
        for (int ai = 0; ai < 2; ++ai) {
            const int G = ai * 2 + wr;
            float p1[8], p2[8];
            if (G > 0) {
                PG8_LAS float* h = halo + ((((G - 1) * 4 + wc) * 2) * 32 + fq * 8);
                const f32x4 r62a = *(PG8_LAS f32x4*)h, r62b = *(PG8_LAS f32x4*)(h + 4), r63a = *(PG8_LAS f32x4*)(h + 32), r63b = *(PG8_LAS f32x4*)(h + 36);
#pragma unroll
                for (int j = 0; j < 4; ++j) { p1[j] = r63a[j]; p1[4 + j] = r63b[j]; p2[j] = fr == 0 ? r62a[j] : r63a[j]; p2[4 + j] = fr == 0 ? r62b[j] : r63b[j]; }
            } else {
#pragma unroll
                for (int j = 0; j < 8; ++j) { p1[j] = 0.f; p2[j] = 0.f; }
            }
#pragma unroll
            for (int m = 0; m < 4; ++m) {
                float gv[8], uv[8];
#pragma unroll
                for (int j = 0; j < 4; ++j) { gv[j] = acc[ai][0][m][0][j]; gv[4 + j] = acc[ai][0][m][1][j]; uv[j] = acc[ai][1][m][0][j]; uv[4 + j] = acc[ai][1][m][1][j]; }
                float o8[8];
#pragma unroll
                for (int j = 0; j < 8; ++j) {
                    const float r1 = __builtin_bit_cast(float, __builtin_amdgcn_update_dpp(0, __builtin_bit_cast(int, gv[j]), 0x121, 0xf, 0xf, false));
                    const float r2 = __builtin_bit_cast(float, __builtin_amdgcn_update_dpp(0, __builtin_bit_cast(int, gv[j]), 0x122, 0xf, 0xf, false));
                    const float g1 = fr >= 1 ? r1 : p1[j], g2 = fr >= 2 ? r2 : p2[j];
                    o8[j] = gelu_tanh_f(w0[j] * g2 + w1[j] * g1 + w2[j] * gv[j] + bb[j]) * uv[j];
                    p1[j] = r1; p2[j] = r2;
                }
                const int row = u.pm * BM + ai * HALF + wr * 64 + m * 16 + fr;
                const bool first2 = (G == 0 && m == 0 && fr < 2), last2 = (G == 3 && m == 3 && fr >= 14);
                if (!first2) { u32x4 w; w.x = pkh(o8[0], o8[1]); w.y = pkh(o8[2], o8[3]); w.z = pkh(o8[4], o8[5]); w.w = pkh(o8[6], o8[7]); *(u32x4*)(act + (size_t)row * DFF + j0) = w; }
                if (first2 || last2) {
                    float* gp = gb + ((size_t)u.pm * 4 + (first2 ? fr : 2 + fr - 14)) * DFF + j0;
                    *(f32x4*)gp = (f32x4){gv[0], gv[1], gv[2], gv[3]}; *(f32x4*)(gp + 4) = (f32x4){gv[4], gv[5], gv[6], gv[7]};
                    if (first2) { float* up = ub + ((size_t)u.pm * 2 + fr) * DFF + j0; *(f32x4*)up = (f32x4){uv[0], uv[1], uv[2], uv[3]}; *(f32x4*)(up + 4) = (f32x4){uv[4], uv[5], uv[6], uv[7]}; }
                }
            }
        }
    }
};

template <class Epi>
__device__ __forceinline__ void gemm_phase(PG8_LAS unsigned char* lds, const Gemm g, const StaticOrder& S_, const Epi& E) {
    int tid_ = threadIdx.x; asm volatile("" : "+v"(tid_));
    const int tid = tid_, wid = __builtin_amdgcn_readfirstlane(tid >> 6), lane = tid & 63, wr = wid >> 2, wc = wid & 3, fr = lane & 15, fq = lane >> 4;
    const int K = g.K, nt = K / BK, lda = g.lda;
    unsigned voffA[2], voffB[2];
#pragma unroll
    for (int i = 0; i < 2; ++i) { int R, C; stage_rc(tid * 16 + i * 8192, R, C); const int Rb = Epi::PERM ? ((R & ~31) + perm32(R & 31)) : R;
        voffA[i] = (unsigned)(R * lda + C) * 2u; voffB[i] = (unsigned)(Rb * K + C) * 2u; }
    const size_t kstep = (size_t)(BK * 2);
    const size_t hstepA = (size_t)HALF * lda * 2, hstepB = (size_t)HALF * K * 2;
    const size_t tstepA = 2 * hstepA, tstepB = 2 * hstepB;
    const unsigned ldsw = (unsigned)wid * 1024u;
    const int aoff = lds_byte(wr * 64 + fr, fq * 8), boff = lds_byte(wc * 32 + fr, fq * 8);
#define PG8_SA(b, h) (((b) * 2 + (h)) * HTB)
#define PG8_SB(b, h) ((4 + (b) * 2 + (h)) * HTB)
#define PG8_STAGE(bufoff, gbase, voff) do { _Pragma("unroll") for (int _i = 0; _i < 2; ++_i) \
        __builtin_amdgcn_global_load_lds((const unsigned*)((const char*)(gbase) + (voff)[_i]), (PG8_LAS unsigned*)(lds + (bufoff) + ldsw + _i * 8192), 16, 0, 0); } while (0)
#define PG8_LDA(dst, b, h) do { _Pragma("unroll") for (int m = 0; m < 4; ++m) _Pragma("unroll") for (int k = 0; k < 2; ++k) dst[m][k] = *(const PG8_LAS half8*)(lds + PG8_SA(b, h) + aoff + m * 2048 + k * 1024); } while (0)
#define PG8_LDB(dst, b, h) do { _Pragma("unroll") for (int n = 0; n < 2; ++n) _Pragma("unroll") for (int k = 0; k < 2; ++k) dst[n][k] = *(const PG8_LAS half8*)(lds + PG8_SB(b, h) + boff + n * 2048 + k * 1024); } while (0)
#define PG8_MMA(ai, bj, At, Bt) do { __builtin_amdgcn_s_setprio(1); _Pragma("unroll") for (int m = 0; m < 4; ++m) _Pragma("unroll") for (int n = 0; n < 2; ++n) _Pragma("unroll") for (int k = 0; k < 2; ++k) \
        acc[ai][bj][m][n] = __builtin_amdgcn_mfma_f32_16x16x32_f16(Bt[n][k], At[m][k], acc[ai][bj][m][n], 0, 0, 0); __builtin_amdgcn_s_setprio(0); } while (0)
#define PG8_WAIT_V(n) asm volatile("s_waitcnt vmcnt(" #n ")" ::: "memory")
#define PG8_WAIT_L(n) asm volatile("s_waitcnt lgkmcnt(" #n ")" ::: "memory")
#define PG8_BAR __builtin_amdgcn_s_barrier()
#define PG8_SCHED __builtin_amdgcn_sched_barrier(0)
    Unit cur, nxt; int ui = 0;
    if (!S_.next(0, cur)) return;
    f32x4 acc[2][2][4][2];
#pragma unroll
    for (int a = 0; a < 2; ++a)
#pragma unroll
        for (int b = 0; b < 2; ++b)
#pragma unroll
            for (int m = 0; m < 4; ++m)
#pragma unroll
                for (int n = 0; n < 2; ++n) acc[a][b][m][n] = (f32x4){0.f, 0.f, 0.f, 0.f};
    half8 At[4][2], B0[2][2], B1[2][2];
    const char* cA = (const char*)g.A + (size_t)cur.pm * tstepA; const char* cB = (const char*)g.Bt + (size_t)cur.pn * tstepB;
    PG8_STAGE(PG8_SB(0, 0), cB, voffB); PG8_STAGE(PG8_SB(0, 1), cB + hstepB, voffB); PG8_STAGE(PG8_SA(0, 0), cA, voffA); PG8_STAGE(PG8_SA(0, 1), cA + hstepA, voffA);
    if (wr == 1) PG8_BAR;
    PG8_WAIT_V(2); PG8_BAR;
    PG8_STAGE(PG8_SB(1, 0), cB + kstep, voffB); PG8_STAGE(PG8_SA(1, 0), cA + kstep, voffA); PG8_STAGE(PG8_SB(1, 1), cB + hstepB + kstep, voffB);
    PG8_WAIT_V(6); PG8_BAR;
    for (;;) {
        const bool has_next = S_.next(ui + 1, nxt);
        const char* nA = has_next ? (const char*)g.A + (size_t)nxt.pm * tstepA : cA; const char* nB = has_next ? (const char*)g.Bt + (size_t)nxt.pn * tstepB : cB;
        for (int t = 0; t < nt; t += 2) {
            const bool last = (t == nt - 2);
            const char* a1 = cA + (size_t)(t + 1) * kstep;
            const char* a2 = last ? nA : cA + (size_t)(t + 2) * kstep; const char* b2 = last ? nB : cB + (size_t)(t + 2) * kstep;
            const char* a3 = a2 + kstep; const char* b3 = b2 + kstep;
            PG8_LDB(B0, 0, 0); PG8_LDB(B1, 0, 1); PG8_SCHED; PG8_LDA(At, 0, 0); PG8_STAGE(PG8_SA(1, 1), a1 + hstepA, voffA);
            PG8_WAIT_V(8); PG8_WAIT_L(0); PG8_BAR; PG8_MMA(0, 0, At, B0); PG8_MMA(0, 1, At, B1); PG8_BAR; PG8_SCHED;
            PG8_LDA(At, 0, 1); PG8_STAGE(PG8_SB(0, 0), b2, voffB); PG8_STAGE(PG8_SB(0, 1), b2 + hstepB, voffB); PG8_STAGE(PG8_SA(0, 0), a2, voffA);
            PG8_WAIT_V(8); PG8_WAIT_L(0); PG8_BAR; PG8_MMA(1, 0, At, B0); PG8_MMA(1, 1, At, B1); PG8_BAR; PG8_SCHED;
            PG8_LDB(B0, 1, 0); PG8_LDB(B1, 1, 1); PG8_SCHED; PG8_LDA(At, 1, 0); PG8_STAGE(PG8_SA(0, 1), a2 + hstepA, voffA);
            PG8_WAIT_V(8); PG8_WAIT_L(0); PG8_BAR; PG8_MMA(0, 0, At, B0); PG8_MMA(0, 1, At, B1); PG8_BAR; PG8_SCHED;
            PG8_LDA(At, 1, 1); PG8_STAGE(PG8_SB(1, 0), b3, voffB); PG8_STAGE(PG8_SB(1, 1), b3 + hstepB, voffB); PG8_STAGE(PG8_SA(1, 0), a3, voffA);
            PG8_WAIT_V(8); PG8_WAIT_L(0); PG8_BAR; PG8_MMA(1, 0, At, B0); PG8_MMA(1, 1, At, B1); PG8_BAR; PG8_SCHED;
        }
        if (wr == 0) PG8_BAR;
        E(acc, cur, wr, wc, fr, fq, lds);
        if (!has_next) break;
#pragma unroll
        for (int a = 0; a < 2; ++a)
#pragma unroll
            for (int b = 0; b < 2; ++b)
#pragma unroll
                for (int m = 0; m < 4; ++m)
#pragma unroll
                    for (int n = 0; n < 2; ++n) acc[a][b][m][n] = (f32x4){0.f, 0.f, 0.f, 0.f};
        cur = nxt; cA = nA; cB = nB; ++ui;
        if (wr == 1) PG8_BAR;
    }
    PG8_WAIT_V(0);
    PG8_BAR;
#undef PG8_SA
#undef PG8_SB
#undef PG8_STAGE
#undef PG8_LDA
#undef PG8_LDB
#undef PG8_MMA
#undef PG8_WAIT_V
#undef PG8_WAIT_L
#undef PG8_BAR
#undef PG8_SCHED
}
}

struct Args {
    const float* x; const float* c; const int* positions; const float* w_in; const float* w_out; const float* w_ada; const float* b_ada; const float* norm_w;
    const float* cmp_w_k; const float* cmp_w_v; const float* cmp_pe_k; const float* cmp_pe_v; const float* sinks; const float* w_gate; const float* w_up;
    const float* conv_w; const float* conv_b; const float* w_down;
    float* out; unsigned char* ws;
    float inv_freq[32];
};

#define LDS_WAIT() asm volatile("s_waitcnt lgkmcnt(0)" ::: "memory")
#define MFMA16(a, b, c) __builtin_amdgcn_mfma_f32_16x16x32_f16((a), (b), (c), 0, 0, 0)
__device__ __forceinline__ float shx(float v, int m) { return __shfl_xor(v, m); }
__device__ __forceinline__ float wave_sum(float v) {
#pragma unroll
    for (int o = 1; o < 64; o <<= 1) v += __shfl_xor(v, o);
    return v;
}
__device__ __forceinline__ int rope_perm(int o) { return 16 * (o >> 5) + 4 * ((o >> 3) & 3) + (o & 3) + 32 * ((o >> 2) & 1); }
__device__ __forceinline__ int win_src_col(int p) {
    const int s = p >> 6, o = p & 63; int base;
    if (s < 10) base = 64 * s; else if (s < 38) base = 652 + 64 * (s - 10); else if (s == 38) return o < 12 ? 640 + o : -1; else return -1;
    const bool rope = (s < 5) || s == 6 || s == 8 || (s >= 10 && s < 22) || (s >= 28 && s < 36);
    return base + (rope ? rope_perm(o) : o);
}

template <bool KPERM = false, class SrcF>
__device__ __forceinline__ void transpose_item(const float* W, int ldw, int K, half_t* WT, int nblk, float* scr, int item, int lane, SrcF src) {
    const int kb = item / nblk, nb = item % nblk, k0 = 64 * kb, n0 = 32 * nb;
    const int sc = src(n0 + (lane & 31));
#pragma unroll 8
    for (int i = 0; i < 32; ++i) { const int kk = 2 * i + (lane >> 5); scr[kk * 33 + (lane & 31)] = sc >= 0 ? W[(size_t)(k0 + (KPERM ? rope_perm(kk) : kk)) * ldw + sc] : 0.f; }
    LDS_WAIT();
    const int c = lane & 7;
#pragma unroll
    for (int j = 0; j < 4; ++j) { const int n = (lane >> 3) + 8 * j; const float* s = scr + (8 * c) * 33 + n;
        u32x4 o; o.x = pg8::pkh(s[0 * 33], s[1 * 33]); o.y = pg8::pkh(s[2 * 33], s[3 * 33]); o.z = pg8::pkh(s[4 * 33], s[5 * 33]); o.w = pg8::pkh(s[6 * 33], s[7 * 33]);
        *(u32x4*)(WT + (size_t)(n0 + n) * K + k0 + 8 * c) = o; }
    LDS_WAIT();
}

template <bool HAS_H, bool HAS_XN, int XL, int XS>
__device__ __forceinline__ void rowwise_phase(const float* xf, half_t* x16, float* xo, const half_t* hs, const float* nwA, const float* gvec, const float* nwB, const float* scv, const float* shv, half_t* xn, int gw, int NW, int lane) {
    for (int b = 0; b < NBATCH; ++b) {
        f32x4 wA[4], gg[4], wB[4], sc1[4], sh[4];
#pragma unroll
        for (int j = 0; j < 4; ++j) {
            if (HAS_H) { wA[j] = *((const f32x4*)nwA + lane + 64 * j); gg[j] = *((const f32x4*)(gvec + (size_t)b * 6144) + lane + 64 * j); }
            if (HAS_XN) { wB[j] = *((const f32x4*)nwB + lane + 64 * j); sc1[j] = *((const f32x4*)(scv + (size_t)b * 6144) + lane + 64 * j) + 1.0f; sh[j] = *((const f32x4*)(shv + (size_t)b * 6144) + lane + 64 * j); }
        }
        const int mend = (b + 1) * S;
        f32x4 xq[4]; half4 xh[4], hq[4];
        {
            const int m0 = b * S + gw;
            if (m0 < mend) {
                if (XL == 0) { const f32x4* xr = (const f32x4*)(xf + (size_t)m0 * D) + lane;
#pragma unroll
                    for (int j = 0; j < 4; ++j) xq[j] = xr[64 * j]; }
                else { const half4* xr = (const half4*)(x16 + (size_t)m0 * D) + lane;
#pragma unroll
                    for (int j = 0; j < 4; ++j) xh[j] = xr[64 * j]; }
                if (HAS_H) { const half4* hr = (const half4*)(hs + (size_t)m0 * D) + lane;
#pragma unroll
                    for (int j = 0; j < 4; ++j) hq[j] = hr[64 * j]; }
            }
        }
        for (int m = b * S + gw; m < mend; m += NW) {
            f32x4 xv[4]; half4 hcur[4];
#pragma unroll
            for (int j = 0; j < 4; ++j) { if (XL == 0) xv[j] = xq[j]; else xv[j] = (f32x4){(float)xh[j][0], (float)xh[j][1], (float)xh[j][2], (float)xh[j][3]}; if (HAS_H) hcur[j] = hq[j]; }
            const int mn = (m + NW < mend) ? m + NW : m;
            {
                if (XL == 0) { const f32x4* xr = (const f32x4*)(xf + (size_t)mn * D) + lane;
#pragma unroll
                    for (int j = 0; j < 4; ++j) xq[j] = xr[64 * j]; }
                else { const half4* xr = (const half4*)(x16 + (size_t)mn * D) + lane;
#pragma unroll
                    for (int j = 0; j < 4; ++j) xh[j] = xr[64 * j]; }
                if (HAS_H) { const half4* hr = (const half4*)(hs + (size_t)mn * D) + lane;
#pragma unroll
                    for (int j = 0; j < 4; ++j) hq[j] = hr[64 * j]; }
            }
            if (HAS_H) {
                f32x4 hv[4]; float ss = 0.f;
#pragma unroll
                for (int j = 0; j < 4; ++j) { const half4 h4 = hcur[j]; hv[j] = (f32x4){(float)h4[0], (float)h4[1], (float)h4[2], (float)h4[3]}; ss += (hv[j][0] * hv[j][0] + hv[j][1] * hv[j][1]) + (hv[j][2] * hv[j][2] + hv[j][3] * hv[j][3]); }
                const float r = 1.0f / sqrtf(wave_sum(ss) * (1.f / D) + RMS_EPS);
#pragma unroll
                for (int j = 0; j < 4; ++j) xv[j] = xv[j] + gg[j] * (hv[j] * r * wA[j]);
            }
            if (XS == 1) {
                u32x2* xs = (u32x2*)(x16 + (size_t)m * D) + lane;
#pragma unroll
                for (int j = 0; j < 4; ++j) { u32x2 pk; pk.x = pg8::pkh(xv[j][0], xv[j][1]); pk.y = pg8::pkh(xv[j][2], xv[j][3]); xs[64 * j] = pk; }
            } else if (XS == 2) {
                f32x4* xs = (f32x4*)(xo + (size_t)m * D) + lane;
#pragma unroll
                for (int j = 0; j < 4; ++j) xs[64 * j] = xv[j];
            }
            if (HAS_XN) {
                float ss = 0.f;
#pragma unroll
                for (int j = 0; j < 4; ++j) ss += (xv[j][0] * xv[j][0] + xv[j][1] * xv[j][1]) + (xv[j][2] * xv[j][2] + xv[j][3] * xv[j][3]);
                const float r = 1.0f / sqrtf(wave_sum(ss) * (1.f / D) + RMS_EPS);
                u32x2* xo2 = (u32x2*)(xn + (size_t)m * D) + lane;
#pragma unroll
                for (int j = 0; j < 4; ++j) { const f32x4 o = (xv[j] * r * wB[j]) * sc1[j] + sh[j]; u32x2 pk; pk.x = pg8::pkh(o[0], o[1]); pk.y = pg8::pkh(o[2], o[3]); xo2[64 * j] = pk; }
            }
        }
    }
}

template <bool PV, class MK>
__device__ __forceinline__ void attn_run(int kb0, int kb_last, const half8 q0, const half8 q1, const half_t* kf, const half_t* vf, MK valid, f32x4 (&o)[4], float& m, float& l, int g) {
    for (int kb = kb0; kb <= kb_last; kb += 32) {
        const half_t* kp = kf + (size_t)(kb >> 5) * 2048;
        const half8 a00 = *(const half8*)kp, a01 = *(const half8*)(kp + 512), a10 = *(const half8*)(kp + 1024), a11 = *(const half8*)(kp + 1536);
        half8 vfr[4];
        if (PV) { const half_t* vp = vf + (size_t)(kb >> 5) * 2048;
#pragma unroll
            for (int dt = 0; dt < 4; ++dt) vfr[dt] = *(const half8*)(vp + dt * 512); }
        const f32x4 z = {0.f, 0.f, 0.f, 0.f};
        f32x4 s0 = MFMA16(a00, q0, z); s0 = MFMA16(a01, q1, s0);
        f32x4 s1 = MFMA16(a10, q0, z); s1 = MFMA16(a11, q1, s1);
        bool v0[4], v1[4]; float mx = -1e30f;
#pragma unroll
        for (int r = 0; r < 4; ++r) { const int key = kb + 4 * g + r; v0[r] = valid(key); v1[r] = valid(key + 16); if (v0[r]) mx = fmaxf(mx, s0[r]); if (v1[r]) mx = fmaxf(mx, s1[r]); }
        mx = fmaxf(mx, shx(mx, 16)); mx = fmaxf(mx, shx(mx, 32));
        const float mn = fmaxf(m, mx); const float corr = __builtin_amdgcn_exp2f(m - mn); m = mn;
        float p0[4], p1[4], ps = 0.f;
#pragma unroll
        for (int r = 0; r < 4; ++r) { p0[r] = v0[r] ? __builtin_amdgcn_exp2f(s0[r] - mn) : 0.f; p1[r] = v1[r] ? __builtin_amdgcn_exp2f(s1[r] - mn) : 0.f; ps += p0[r] + p1[r]; }
        l = l * corr + ps;
        if (PV) {
            const half8 pf = {(half_t)p0[0], (half_t)p0[1], (half_t)p0[2], (half_t)p0[3], (half_t)p1[0], (half_t)p1[1], (half_t)p1[2], (half_t)p1[3]};
#pragma unroll
            for (int dt = 0; dt < 4; ++dt) { o[dt] = o[dt] * corr; o[dt] = MFMA16(vfr[dt], pf, o[dt]); }
        }
    }
}

constexpr float RESC_THR = 12.0f;
template <int MODE, bool PV, class MK, class KB>
__device__ __forceinline__ void attn_run2(int nit, KB kbof, int maxblk, const half8 q0, const half8 q1, const half_t* kf, const half_t* vf, MK valid, f32x4 (&o)[4], float& m, float& l, int g,
                                          float* impq = nullptr, bool impw = false, int lane = 0) {
    if (nit <= 0) return;
    half8 ka[8], va[8];
    int kbA = kbof(0);
    {
        const int bA = kbA >> 5, bB = (bA + 1 <= maxblk) ? bA + 1 : maxblk;
        const half_t* kpA = kf + (size_t)bA * 2048; const half_t* kpB = kf + (size_t)bB * 2048;
#pragma unroll
        for (int i = 0; i < 4; ++i) { ka[i] = *(const half8*)(kpA + i * 512); ka[4 + i] = *(const half8*)(kpB + i * 512); }
        if (PV) { const half_t* vpA = vf + (size_t)bA * 2048; const half_t* vpB = vf + (size_t)bB * 2048;
#pragma unroll
            for (int i = 0; i < 4; ++i) { va[i] = *(const half8*)(vpA + i * 512); va[4 + i] = *(const half8*)(vpB + i * 512); } }
    }
    float carry = 0.f;
    for (int it = 0; it < nit; ++it) {
        const int kbN = kbof((it + 1 < nit) ? it + 1 : it);
        const int nbA = kbN >> 5, nbB = (nbA + 1 <= maxblk) ? nbA + 1 : maxblk;
        const f32x4 z = {0.f, 0.f, 0.f, 0.f};
        f32x4 s[4];
#pragma unroll
        for (int t = 0; t < 4; ++t) { s[t] = MFMA16(ka[2 * t], q0, z); s[t] = MFMA16(ka[2 * t + 1], q1, s[t]); }
        {
            const half_t* kpA = kf + (size_t)nbA * 2048; const half_t* kpB = kf + (size_t)nbB * 2048;
#pragma unroll
            for (int i = 0; i < 4; ++i) { ka[i] = *(const half8*)(kpA + i * 512); ka[4 + i] = *(const half8*)(kpB + i * 512); }
        }
        float p[4][4];
        if (MODE == 0) {
            bool vld[4][4]; float mx = -1e30f;
#pragma unroll
            for (int t = 0; t < 4; ++t)
#pragma unroll
                for (int r = 0; r < 4; ++r) { vld[t][r] = valid(kbA + 16 * t + 4 * g + r); if (vld[t][r]) mx = fmaxf(mx, s[t][r]); }
            if (__ballot(mx > m + RESC_THR) != 0ull) {
                mx = fmaxf(mx, shx(mx, 16)); mx = fmaxf(mx, shx(mx, 32));
                const float mn = fmaxf(m, mx); const float corr = __builtin_amdgcn_exp2f(m - mn); m = mn;
                l = l * corr;
                if (PV) {
#pragma unroll
                    for (int dt = 0; dt < 4; ++dt) o[dt] = o[dt] * corr;
                }
            }
            float ps = 0.f;
#pragma unroll
            for (int t = 0; t < 4; ++t)
#pragma unroll
                for (int r = 0; r < 4; ++r) { p[t][r] = vld[t][r] ? __builtin_amdgcn_exp2f(s[t][r] - m) : 0.f; ps += p[t][r]; }
            l = l + ps;
        } else {
#pragma unroll
            for (int t = 0; t < 4; ++t)
#pragma unroll
                for (int r = 0; r < 4; ++r) p[t][r] = valid(kbA + 16 * t + 4 * g + r) ? __builtin_amdgcn_exp2f(s[t][r] - m) * l : 0.f;
        }
        if (PV) {
            const half8 pfA = {(half_t)p[0][0], (half_t)p[0][1], (half_t)p[0][2], (half_t)p[0][3], (half_t)p[1][0], (half_t)p[1][1], (half_t)p[1][2], (half_t)p[1][3]};
            const half8 pfB = {(half_t)p[2][0], (half_t)p[2][1], (half_t)p[2][2], (half_t)p[2][3], (half_t)p[3][0], (half_t)p[3][1], (half_t)p[3][2], (half_t)p[3][3]};
#pragma unroll
            for (int dt = 0; dt < 4; ++dt) { o[dt] = MFMA16(va[dt], pfA, o[dt]); o[dt] = MFMA16(va[4 + dt], pfB, o[dt]); }
            const half_t* vpA = vf + (size_t)nbA * 2048; const half_t* vpB = vf + (size_t)nbB * 2048;
#pragma unroll
            for (int i = 0; i < 4; ++i) { va[i] = *(const half8*)(vpA + i * 512); va[4 + i] = *(const half8*)(vpB + i * 512); }
        }
        if (MODE == 1) {
            float A[4], B[4], Bup[4], Btop[4];
#pragma unroll
            for (int t = 0; t < 4; ++t) { A[t] = (p[t][0] + p[t][1]) + (p[t][2] + p[t][3]); B[t] = p[t][3]; A[t] += shx(A[t], 1); A[t] += shx(A[t], 2); B[t] += shx(B[t], 1); B[t] += shx(B[t], 2);
                Bup[t] = __shfl(B[t], (lane - 16) & 63); Btop[t] = __shfl(B[t], (lane & 15) + 48); }
#pragma unroll
            for (int t = 0; t < 4; ++t) { const float prev = g > 0 ? Bup[t] : (t == 0 ? carry : Btop[t > 0 ? t - 1 : 0]); if (impw) impq[(kbA >> 2) + 4 * t + g] = A[t] + prev; }
            carry = Btop[3];
        }
        kbA = kbN;
    }
}

template <int NS, int MODE, class MK, class KB>
__device__ __forceinline__ void attn_runN(int nit, KB kbof, int maxblk, const half8 (&qf)[NS][2], const half_t* kf, const half_t* vf, MK valid, f32x4 (&o)[NS][4], float (&m)[NS], float (&l)[NS], int g,
                                          float* impb = nullptr, int imps = 0, bool impw = false, int lane = 0) {
    if (nit <= 0) return;
    constexpr bool PV = MODE != 2;
    half8 ka[8], va[8];
    int kbA = kbof(0);
    {
        const int bA = kbA >> 5, bB = (bA + 1 <= maxblk) ? bA + 1 : maxblk;
        const half_t* kpA = kf + (size_t)bA * 2048; const half_t* kpB = kf + (size_t)bB * 2048;
#pragma unroll
        for (int i = 0; i < 4; ++i) { ka[i] = *(const half8*)(kpA + i * 512); ka[4 + i] = *(const half8*)(kpB + i * 512); }
        if (PV) { const half_t* vpA = vf + (size_t)bA * 2048; const half_t* vpB = vf + (size_t)bB * 2048;
#pragma unroll
            for (int i = 0; i < 4; ++i) { va[i] = *(const half8*)(vpA + i * 512); va[4 + i] = *(const half8*)(vpB + i * 512); } }
    }
    float carry[NS];
#pragma unroll
    for (int s_ = 0; s_ < NS; ++s_) carry[s_] = 0.f;
    for (int it = 0; it < nit; ++it) {
        const int kbN = kbof((it + 1 < nit) ? it + 1 : it);
        const int nbA = kbN >> 5, nbB = (nbA + 1 <= maxblk) ? nbA + 1 : maxblk;
        const f32x4 z = {0.f, 0.f, 0.f, 0.f};
#pragma unroll
        for (int s_ = 0; s_ < NS; ++s_) {
            f32x4 s[4];
#pragma unroll
            for (int t = 0; t < 4; ++t) { s[t] = MFMA16(ka[2 * t], qf[s_][0], z); s[t] = MFMA16(ka[2 * t + 1], qf[s_][1], s[t]); }
            if (s_ == NS - 1) {
                const half_t* kpA = kf + (size_t)nbA * 2048; const half_t* kpB = kf + (size_t)nbB * 2048;
#pragma unroll
                for (int i = 0; i < 4; ++i) { ka[i] = *(const half8*)(kpA + i * 512); ka[4 + i] = *(const half8*)(kpB + i * 512); }
            }
            if (MODE != 1) {
                float mx = -1e30f;
#pragma unroll
                for (int t = 0; t < 4; ++t)
#pragma unroll
                    for (int r = 0; r < 4; ++r) { if (valid(s_, kbA + 16 * t + 4 * g + r)) mx = fmaxf(mx, s[t][r]); }
                if (__ballot(mx > m[s_] + RESC_THR) != 0ull) {
                    mx = fmaxf(mx, shx(mx, 16)); mx = fmaxf(mx, shx(mx, 32));
                    const float mn = fmaxf(m[s_], mx); const float corr = __builtin_amdgcn_exp2f(m[s_] - mn); m[s_] = mn; l[s_] = l[s_] * corr;
                    if (PV) {
#pragma unroll
                        for (int dt = 0; dt < 4; ++dt) o[s_][dt] = o[s_][dt] * corr;
                    }
                }
            }
            float p[4][4]; float ps = 0.f;
#pragma unroll
            for (int t = 0; t < 4; ++t)
#pragma unroll
                for (int r = 0; r < 4; ++r) { p[t][r] = valid(s_, kbA + 16 * t + 4 * g + r) ? __builtin_amdgcn_exp2f(s[t][r] - m[s_]) : 0.f; if (MODE == 1) p[t][r] *= l[s_]; ps += p[t][r]; }
            if (MODE != 1) l[s_] = l[s_] + ps;
            if (PV) {
                const half8 pfA = {(half_t)p[0][0], (half_t)p[0][1], (half_t)p[0][2], (half_t)p[0][3], (half_t)p[1][0], (half_t)p[1][1], (half_t)p[1][2], (half_t)p[1][3]};
                const half8 pfB = {(half_t)p[2][0], (half_t)p[2][1], (half_t)p[2][2], (half_t)p[2][3], (half_t)p[3][0], (half_t)p[3][1], (half_t)p[3][2], (half_t)p[3][3]};
#pragma unroll
                for (int dt = 0; dt < 4; ++dt) { o[s_][dt] = MFMA16(va[dt], pfA, o[s_][dt]); o[s_][dt] = MFMA16(va[4 + dt], pfB, o[s_][dt]); }
            }
            if (MODE == 1) {
                float A[4], B[4], Bup[4], Btop[4];
#pragma unroll
                for (int t = 0; t < 4; ++t) { A[t] = (p[t][0] + p[t][1]) + (p[t][2] + p[t][3]); B[t] = p[t][3]; A[t] += shx(A[t], 1); A[t] += shx(A[t], 2); B[t] += shx(B[t], 1); B[t] += shx(B[t], 2);
                    Bup[t] = __shfl(B[t], (lane - 16) & 63); Btop[t] = __shfl(B[t], (lane & 15) + 48); }
#pragma unroll
                for (int t = 0; t < 4; ++t) { const float prev = g > 0 ? Bup[t] : (t == 0 ? carry[s_] : Btop[t > 0 ? t - 1 : 0]); if (impw) impb[s_ * imps + (kbA >> 2) + 4 * t + g] = A[t] + prev; }
                carry[s_] = Btop[3];
            }
        }
        if (PV) {
            const half_t* vpA = vf + (size_t)nbA * 2048; const half_t* vpB = vf + (size_t)nbB * 2048;
#pragma unroll
            for (int i = 0; i < 4; ++i) { va[i] = *(const half8*)(vpA + i * 512); va[4 + i] = *(const half8*)(vpB + i * 512); }
        }
        kbA = kbN;
    }
}

__device__ __forceinline__ half8 fp8x8_to_half8(u32x2 x) {
    const half2v a = __builtin_amdgcn_cvt_scalef32_pk_f16_fp8((int)x.x, 1.0f, false), b = __builtin_amdgcn_cvt_scalef32_pk_f16_fp8((int)x.x, 1.0f, true);
    const half2v c = __builtin_amdgcn_cvt_scalef32_pk_f16_fp8((int)x.y, 1.0f, false), d = __builtin_amdgcn_cvt_scalef32_pk_f16_fp8((int)x.y, 1.0f, true);
    return (half8){a.x, a.y, b.x, b.y, c.x, c.y, d.x, d.y};
}
template <class KB>
__device__ __forceinline__ void sel_run(int nit, KB kbof, const half8 (&qf)[2][2], const unsigned char* kf, const unsigned char* vf, const int (&tqs)[2], int qq,
                                        f32x4 (&o)[2][4], float (&m)[2], float (&l)[2], int g) {
    if (nit <= 0) return;
    u32x2 ka[8], va[8];
    int eA = kbof(0);
    int kbA = 64 * (eA & 255);
    {
        const unsigned char* kp = kf + (size_t)(kbA >> 5) * 2048; const unsigned char* vp = vf + (size_t)(kbA >> 5) * 2048;
#pragma unroll
        for (int i = 0; i < 8; ++i) { ka[i] = *(const u32x2*)(kp + i * 512); va[i] = *(const u32x2*)(vp + i * 512); }
    }
    for (int it = 0; it < nit; ++it) {
        const int eN = kbof((it + 1 < nit) ? it + 1 : it);
        const int kbN = 64 * (eN & 255);
        const unsigned maskA = (unsigned)eA >> 8;
        bool selq[2], need[2];
#pragma unroll
        for (int s_ = 0; s_ < 2; ++s_) { selq[s_] = ((maskA >> (4 * s_ + qq)) & 1u) != 0u; need[s_] = ((maskA >> (4 * s_)) & 15u) != 0u; }
        half8 kh[8];
#pragma unroll
        for (int i = 0; i < 8; ++i) kh[i] = fp8x8_to_half8(ka[i]);
        {
            const unsigned char* kp = kf + (size_t)(kbN >> 5) * 2048;
#pragma unroll
            for (int i = 0; i < 8; ++i) ka[i] = *(const u32x2*)(kp + i * 512);
        }
        const f32x4 z = {0.f, 0.f, 0.f, 0.f};
        f32x4 s[2][4];
#pragma unroll
        for (int s_ = 0; s_ < 2; ++s_)
            if (need[s_]) {
#pragma unroll
                for (int t = 0; t < 4; ++t) { s[s_][t] = MFMA16(kh[2 * t], qf[s_][0], z); s[s_][t] = MFMA16(kh[2 * t + 1], qf[s_][1], s[s_][t]); }
            }
        half8 vh[8];
#pragma unroll
        for (int i = 0; i < 8; ++i) vh[i] = fp8x8_to_half8(va[i]);
        {
            const unsigned char* vp = vf + (size_t)(kbN >> 5) * 2048;
#pragma unroll
            for (int i = 0; i < 8; ++i) va[i] = *(const u32x2*)(vp + i * 512);
        }
#pragma unroll
        for (int s_ = 0; s_ < 2; ++s_)
            if (need[s_]) {
                float p[4][4]; float mx = -1e30f;
                const int klim = selq[s_] ? tqs[s_] - kbA - 4 * g : -1;
#pragma unroll
                for (int t = 0; t < 4; ++t)
#pragma unroll
                    for (int r = 0; r < 4; ++r) { if (16 * t + r <= klim) mx = fmaxf(mx, s[s_][t][r]); }
                if (__ballot(mx > m[s_] + RESC_THR) != 0ull) {
                    mx = fmaxf(mx, shx(mx, 16)); mx = fmaxf(mx, shx(mx, 32));
                    const float mn = fmaxf(m[s_], mx); const float corr = __builtin_amdgcn_exp2f(m[s_] - mn); m[s_] = mn;
                    l[s_] = l[s_] * corr;
#pragma unroll
                    for (int dt = 0; dt < 4; ++dt) o[s_][dt] = o[s_][dt] * corr;
                }
                float ps = 0.f;
#pragma unroll
                for (int t = 0; t < 4; ++t)
#pragma unroll
                    for (int r = 0; r < 4; ++r) { p[t][r] = (16 * t + r <= klim) ? __builtin_amdgcn_exp2f(s[s_][t][r] - m[s_]) : 0.f; ps += p[t][r]; }
                l[s_] = l[s_] + ps;
                const half8 pfA = {(half_t)p[0][0], (half_t)p[0][1], (half_t)p[0][2], (half_t)p[0][3], (half_t)p[1][0], (half_t)p[1][1], (half_t)p[1][2], (half_t)p[1][3]};
                const half8 pfB = {(half_t)p[2][0], (half_t)p[2][1], (half_t)p[2][2], (half_t)p[2][3], (half_t)p[3][0], (half_t)p[3][1], (half_t)p[3][2], (half_t)p[3][3]};
#pragma unroll
                for (int dt = 0; dt < 4; ++dt) { o[s_][dt] = MFMA16(vh[dt], pfA, o[s_][dt]); o[s_][dt] = MFMA16(vh[4 + dt], pfB, o[s_][dt]); }
            }
        kbA = kbN; eA = eN;
    }
}

struct ACtx { const half_t* proj; const half_t* kc; const half_t* vct; const half_t* vt; const half_t* kf; half_t* mix; float* lse; const float* sinks; const unsigned char* ks8; const unsigned char* vs8; };

__device__ __forceinline__ void a_unit(const ACtx& X, int b, int t0, float* ldsw, int lane) {
    const int c = lane & 15, g = lane >> 4, loff = (c * 4 + g) * 8;
    float* outT = ldsw;
    float* impL = ldsw + 2048;
    unsigned* qbits = (unsigned*)(ldsw + 4096);
    int* ulist = (int*)(ldsw + 4160);
    const size_t rowb = (size_t)b * S;
    const half_t* P = X.proj;
    qbits[lane] = 0u;
    for (int i = lane; i < 2048; i += 64) impL[i] = 0.f;
    {
        const int qq = c >> 2, h = c & 3;
        half8 qf[2][2]; int tqs[2], nval[2];
#pragma unroll
        for (int s_ = 0; s_ < 2; ++s_) { tqs[s_] = t0 + 4 * s_ + qq; nval[s_] = (tqs[s_] >= 31) ? ((tqs[s_] - 31) >> 4) : -1;
            const half_t* qrow = P + (rowb + tqs[s_]) * NPROJ + h * 64; qf[s_][0] = *(const half8*)(qrow + 8 * g); qf[s_][1] = *(const half8*)(qrow + 32 + 8 * g); }
        const int tqmax = t0 + 7;
        const int nlast = (tqmax >= 31) ? ((tqmax - 31) >> 4) : -1;
        const half_t* kcb = X.kc + (size_t)b * 1024 * 64 + loff;
        const half_t* vcb = X.vct + (size_t)b * 64 * 1024 + loff;
        auto valid = [&](int s_, int n) { return n <= nval[s_]; };
        float m[2] = {-1e30f, -1e30f}, l[2] = {0.f, 0.f}; f32x4 o[2][4];
#pragma unroll
        for (int s_ = 0; s_ < 2; ++s_)
#pragma unroll
            for (int dt = 0; dt < 4; ++dt) o[s_][dt] = (f32x4){0.f, 0.f, 0.f, 0.f};
        const int nitc = (nlast >= 0) ? ((nlast >> 6) + 1) : 0;
        auto kbc = [&](int it) { return 64 * it; };
        attn_runN<2, 2>(nitc, kbc, 31, qf, kcb, vcb, valid, o, m, l, g);
#pragma unroll
        for (int s_ = 0; s_ < 2; ++s_) { float ls = l[s_]; ls += shx(ls, 16); ls += shx(ls, 32); l[s_] = ls > 0.f ? 1.f / ls : 0.f; }
        attn_runN<2, 1>(nitc, kbc, 31, qf, kcb, vcb, valid, o, m, l, g, impL + qq * 256, 1024, h == 0, lane);
#pragma unroll
        for (int s_ = 0; s_ < 2; ++s_) {
            const float gc = (float)P[(rowb + tqs[s_]) * NPROJ + 38 * 64 + h * 3 + 0];
#pragma unroll
            for (int dt = 0; dt < 4; ++dt)
#pragma unroll
                for (int r = 0; r < 4; ++r) outT[((4 * s_ + qq) * 4 + h) * 64 + 16 * dt + 4 * g + r] = gc * o[s_][dt][r];
        }
    }
    LDS_WAIT(); __builtin_amdgcn_wave_barrier();
    for (int qi = 0; qi < 8; ++qi) {
        const int tqq = t0 + qi, cur = tqq >> 6, cnt = (cur + 1 < 16) ? cur + 1 : 16;
        unsigned key[4];
#pragma unroll
        for (int i = 0; i < 4; ++i) { const int j = lane + 64 * i; const float v = (j == 0 || j == cur || j == cur - 1) ? 1e4f : fmaxf(impL[qi * 256 + j], 0.f); key[i] = (j > cur) ? 0u : (__float_as_uint(v) + 1u); }
        unsigned T = 0u;
        for (int bit = 30; bit >= 0; --bit) {
            const unsigned cand = T | (1u << bit);
            int cge = 0;
#pragma unroll
            for (int i = 0; i < 4; ++i) cge += __popcll(__ballot(key[i] >= cand));
            if (cge >= cnt) T = cand;
        }
        int ngt = 0;
#pragma unroll
        for (int i = 0; i < 4; ++i) ngt += __popcll(__ballot(key[i] > T));
        int need = cnt - ngt, base = 0;
#pragma unroll
        for (int i = 0; i < 4; ++i) {
            const unsigned long long Me = __ballot(key[i] == T);
            const int pos = base + (int)__builtin_amdgcn_mbcnt_hi((unsigned)(Me >> 32), __builtin_amdgcn_mbcnt_lo((unsigned)Me, 0u));
            const bool sel = (key[i] > T) || (key[i] == T && pos < need);
            const unsigned long long Ms = __ballot(sel);
            if (lane == 0) { qbits[qi * 8 + 2 * i] = (unsigned)Ms; qbits[qi * 8 + 2 * i + 1] = (unsigned)(Ms >> 32); }
            base += __popcll(Me);
        }
    }
    LDS_WAIT(); __builtin_amdgcn_wave_barrier();
    {
        int nun = 0;
#pragma unroll
        for (int i = 0; i < 4; ++i) {
            const int j = lane + 64 * i, w = j >> 5; unsigned u = 0u;
#pragma unroll
            for (int q = 0; q < 8; ++q) u |= ((qbits[q * 8 + w] >> (j & 31)) & 1u) << q;
            const bool pr = u != 0u;
            const unsigned long long Mb = __ballot(pr);
            const int pos = nun + (int)__builtin_amdgcn_mbcnt_hi((unsigned)(Mb >> 32), __builtin_amdgcn_mbcnt_lo((unsigned)Mb, 0u));
            if (pr) ulist[pos] = j | (int)(u << 8);
            nun += __popcll(Mb);
        }
        LDS_WAIT(); __builtin_amdgcn_wave_barrier();
        const int qq = c >> 2, h = c & 3;
        half8 qf[2][2]; int tqs[2];
#pragma unroll
        for (int s_ = 0; s_ < 2; ++s_) { tqs[s_] = t0 + 4 * s_ + qq; const half_t* qrow = P + (rowb + tqs[s_]) * NPROJ + h * 64; qf[s_][0] = *(const half8*)(qrow + 8 * g); qf[s_][1] = *(const half8*)(qrow + 32 + 8 * g); }
        const unsigned char* kb_ = X.ks8 + (size_t)b * 64 * S + loff;
        const unsigned char* vb_ = X.vs8 + (size_t)b * 64 * S + loff;
        f32x4 o[2][4]; float m[2] = {-1e30f, -1e30f}, l[2] = {0.f, 0.f};
#pragma unroll
        for (int s_ = 0; s_ < 2; ++s_)
#pragma unroll
            for (int dt = 0; dt < 4; ++dt) o[s_][dt] = (f32x4){0.f, 0.f, 0.f, 0.f};
        auto kbs = [&](int it) { return __builtin_amdgcn_readfirstlane(ulist[it]); };
        sel_run(nun, kbs, qf, kb_, vb_, tqs, qq, o, m, l, g);
#pragma unroll
        for (int s_ = 0; s_ < 2; ++s_) {
            float ls = l[s_]; ls += shx(ls, 16); ls += shx(ls, 32);
            const float gs = (float)P[(rowb + tqs[s_]) * NPROJ + 38 * 64 + h * 3 + 1] / fmaxf(ls, 1e-30f);
#pragma unroll
            for (int dt = 0; dt < 4; ++dt)
#pragma unroll
                for (int r = 0; r < 4; ++r) outT[((4 * s_ + qq) * 4 + h) * 64 + 16 * dt + 4 * g + r] += gs * o[s_][dt][r];
        }
        LDS_WAIT(); __builtin_amdgcn_wave_barrier();
    }
    {
        const int q8 = c & 7, tq = t0 + q8;
        half8 qf[2][2];
#pragma unroll
        for (int s_ = 0; s_ < 2; ++s_) { const half_t* qrow = P + (rowb + tq) * NPROJ + (2 * s_ + (c >> 3)) * 64; qf[s_][0] = *(const half8*)(qrow + 8 * g); qf[s_][1] = *(const half8*)(qrow + 32 + 8 * g); }
        const half_t* kb_ = X.kf + (size_t)(1 * 2 + b) * 64 * S + loff;
        const half_t* vb_ = X.vt + (size_t)(1 * 2 + b) * 64 * S + loff;
        auto valid = [&](int, int key) { return key <= tq && tq - key <= 511; };
        float m[2] = {-1e30f, -1e30f}, l[2] = {0.f, 0.f}; f32x4 o[2][4];
#pragma unroll
        for (int s_ = 0; s_ < 2; ++s_)
#pragma unroll
            for (int dt = 0; dt < 4; ++dt) o[s_][dt] = (f32x4){0.f, 0.f, 0.f, 0.f};
        const int lo_ = t0 - 511; const int kb0 = (lo_ > 0 ? lo_ : 0) & ~31;
        auto kbw = [&](int it) { return kb0 + 64 * it; };
        attn_runN<2, 0>(((((t0 + 7) >> 5) - (kb0 >> 5)) >> 1) + 1, kbw, S / 32 - 1, qf, kb_, vb_, valid, o, m, l, g);
#pragma unroll
        for (int s_ = 0; s_ < 2; ++s_) {
            const int h = 2 * s_ + (c >> 3);
            float ls = l[s_]; ls += shx(ls, 16); ls += shx(ls, 32);
            const float gwv = (float)P[(rowb + tq) * NPROJ + 38 * 64 + h * 3 + 2] / ls;
#pragma unroll
            for (int dt = 0; dt < 4; ++dt)
#pragma unroll
                for (int r = 0; r < 4; ++r) outT[(q8 * 4 + h) * 64 + 16 * dt + 4 * g + r] += gwv * o[s_][dt][r];
        }
        LDS_WAIT(); __builtin_amdgcn_wave_barrier();
    }
#pragma unroll
    for (int q = 0; q < 8; ++q) {
        const f32x4 v = *(const f32x4*)(outT + q * 256 + 4 * lane);
        u32x2 pk; pk.x = pg8::pkh(v[0], v[1]); pk.y = pg8::pkh(v[2], v[3]);
        *(u32x2*)(X.mix + (rowb + t0 + q) * D + 4 * lane) = pk;
    }
    LDS_WAIT(); __builtin_amdgcn_wave_barrier();
}

__device__ __forceinline__ void b_unit(const ACtx& X, int b, int h6, int fb, int lane) {
    const int c = lane & 15, g = lane >> 4;
    const int sh = 2 * (h6 >> 1), dil = 1 << sh, n = S >> sh, bpc = n >> 5;
    const int r = fb / bpc, i0 = (fb % bpc) * 32;
    const size_t rowb = (size_t)b * S;
    const half_t* P = X.proj;
    half8 qf[2][2]; int iqs[2], tls[2];
#pragma unroll
    for (int s_ = 0; s_ < 2; ++s_) { iqs[s_] = i0 + 16 * s_ + c; tls[s_] = iqs[s_] * dil + r; const half_t* qrow = P + (rowb + tls[s_]) * NPROJ + (10 + h6) * 64; qf[s_][0] = *(const half8*)(qrow + 8 * g); qf[s_][1] = *(const half8*)(qrow + 32 + 8 * g); }
    const int loff = (c * 4 + g) * 8;
    const half_t* kb_ = X.kf + (size_t)((2 + h6) * 2 + b) * 64 * S + (size_t)r * n * 64 + loff;
    const half_t* vb_ = X.vt + (size_t)((2 + h6) * 2 + b) * 64 * S + (size_t)r * n * 64 + loff;
    auto valid = [&](int s_, int kf) { return kf <= iqs[s_] && iqs[s_] - kf <= 128; };
    float m[2] = {-1e30f, -1e30f}, l[2] = {0.f, 0.f}; f32x4 o[2][4];
#pragma unroll
    for (int s_ = 0; s_ < 2; ++s_)
#pragma unroll
        for (int dt = 0; dt < 4; ++dt) o[s_][dt] = (f32x4){0.f, 0.f, 0.f, 0.f};
    const int lo_ = i0 - 128; const int kb0 = (lo_ > 0 ? lo_ : 0) & ~31;
    auto kbw = [&](int it) { return kb0 + 64 * it; };
    attn_runN<2, 0>(((((i0 + 31) >> 5) - (kb0 >> 5)) >> 1) + 1, kbw, (n >> 5) - 1, qf, kb_, vb_, valid, o, m, l, g);
#pragma unroll
    for (int s_ = 0; s_ < 2; ++s_) {
        float ls = l[s_]; ls += shx(ls, 16); ls += shx(ls, 32);
        const float inv = 1.f / ls;
        half_t* op = X.mix + (rowb + tls[s_]) * D + (4 + h6) * 64 + 4 * g;
#pragma unroll
        for (int dt = 0; dt < 4; ++dt) { u32x2 pk; pk.x = pg8::pkh(o[s_][dt][0] * inv, o[s_][dt][1] * inv); pk.y = pg8::pkh(o[s_][dt][2] * inv, o[s_][dt][3] * inv); *(u32x2*)(op + 16 * dt) = pk; }
        if (g == 0) X.lse[(rowb + tls[s_]) * 6 + h6] = m[s_] + __builtin_amdgcn_logf(ls);
    }
}

__device__ __forceinline__ void c_unit(const ACtx& X, int b, int kvh, int qb, int lane) {
    const int c = lane & 15, g = lane >> 4;
    const int t0 = qb * 16, tq = t0 + c;
    const size_t rowb = (size_t)b * S;
    const half_t* P = X.proj;
    half8 qf[3][2]; float m[3], l[3]; f32x4 o[3][4];
#pragma unroll
    for (int s_ = 0; s_ < 3; ++s_) { const half_t* qrow = P + (rowb + tq) * NPROJ + (28 + 3 * kvh + s_) * 64; qf[s_][0] = *(const half8*)(qrow + 8 * g); qf[s_][1] = *(const half8*)(qrow + 32 + 8 * g);
        m[s_] = X.sinks[3 * kvh + s_] * LOG2E; l[s_] = (g == 0) ? 1.f : 0.f;
#pragma unroll
        for (int dt = 0; dt < 4; ++dt) o[s_][dt] = (f32x4){0.f, 0.f, 0.f, 0.f}; }
    const int loff = (c * 4 + g) * 8;
    const half_t* kb_ = X.kf + (size_t)((8 + kvh) * 2 + b) * 64 * S + loff;
    const half_t* vb_ = X.vt + (size_t)((8 + kvh) * 2 + b) * 64 * S + loff;
    auto valid = [&](int, int key) { return key <= tq && tq - key <= 127; };
    const int lo_ = t0 - 127; const int kb0 = (lo_ > 0 ? lo_ : 0) & ~31;
    auto kbw = [&](int it) { return kb0 + 64 * it; };
    attn_runN<3, 0>(((((t0 + 15) >> 5) - (kb0 >> 5)) >> 1) + 1, kbw, S / 32 - 1, qf, kb_, vb_, valid, o, m, l, g);
#pragma unroll
    for (int s_ = 0; s_ < 3; ++s_) {
        float ls = l[s_]; ls += shx(ls, 16); ls += shx(ls, 32);
        const float inv = 1.f / ls;
        half_t* op = X.mix + (rowb + tq) * D + (10 + 3 * kvh + s_) * 64 + 4 * g;
#pragma unroll
        for (int dt = 0; dt < 4; ++dt) { u32x2 pk; pk.x = pg8::pkh(o[s_][dt][0] * inv, o[s_][dt][1] * inv); pk.y = pg8::pkh(o[s_][dt][2] * inv, o[s_][dt][3] * inv); *(u32x2*)(op + 16 * dt) = pk; }
    }
}

__device__ __forceinline__ float gelu_tanh(float v) {
    const float z = 0.7978845608028654f * (v + 0.044715f * v * v * v);
    const float t = __expf(2.f * z);
    const float th = 1.f - 2.f / (t + 1.f);
    return 0.5f * v * (1.f + th);
}

#ifndef PH
#define PH 0xFFFF
#endif
#ifndef REP
#define REP 0
#endif
typedef const Args __attribute__((address_space(4)))* ArgsP;
__device__ __forceinline__ ArgsP largs() { auto p = __builtin_amdgcn_kernarg_segment_ptr(); asm volatile("" : "+s"(p)); return (ArgsP)p; }
struct Ids { int tid, lane, wave, G, NW, gw, gtid, NT; };
__device__ __forceinline__ Ids make_ids() {
    Ids I; int t = threadIdx.x; asm volatile("" : "+v"(t));
    int bid = blockIdx.x; asm volatile("" : "+s"(bid));
    I.tid = t; I.lane = t & 63; I.wave = __builtin_amdgcn_readfirstlane(t >> 6); I.G = gridDim.x; I.NW = I.G * NWAVES; I.gw = bid * NWAVES + I.wave;
    I.gtid = bid * NTHREADS + t; I.NT = I.G * NTHREADS; return I;
}
__device__ __forceinline__ int opaque_bid() { int bid = blockIdx.x; asm volatile("" : "+s"(bid)); return bid; }
__device__ __forceinline__ unsigned char* ws_base(ArgsP a) {
    const unsigned long long v = (unsigned long long)a->ws;
    unsigned lo = __builtin_amdgcn_readfirstlane((unsigned)v), hi = __builtin_amdgcn_readfirstlane((unsigned)(v >> 32));
    asm volatile("" : "+s"(lo), "+s"(hi));
    return (unsigned char*)(((unsigned long long)hi << 32) | lo);
}

__device__ __forceinline__ void phase_p0a(ArgsP a, unsigned char* lds) {
    const Ids I = make_ids(); unsigned char* ws = ws_base(a);
    const int tid = I.tid, lane = I.lane, wave = I.wave, G = I.G;
    half_t* wt_in = (half_t*)(ws + WS_WT_IN); half_t* wt_out = (half_t*)(ws + WS_WT_OUT); half_t* wt_dn = (half_t*)(ws + WS_WT_DN);
    float* cosT = (float*)(ws + WS_COS); float* sinT = (float*)(ws + WS_SIN); float* ada = (float*)(ws + WS_ADA);
    float* red = (float*)(lds + 80 * 1024);
    for (int item = opaque_bid(); item < DEPTH * 96; item += G) {
        const int l = item / 96, jc = item % 96, jl = tid & 63, j = jc * 64 + jl, kg = tid >> 6;
        float a0 = 0.f, a1 = 0.f;
        for (int k0 = kg * 128; k0 < kg * 128 + 128; k0 += 16) {
            float w[16];
#pragma unroll
            for (int u = 0; u < 16; ++u) w[u] = a->w_ada[((size_t)l * D + k0 + u) * 6144 + j];
#pragma unroll
            for (int u = 0; u < 16; ++u) { const float c0 = a->c[k0 + u], c1 = a->c[D + k0 + u]; a0 += (c0 / (1.f + __expf(-c0))) * w[u]; a1 += (c1 / (1.f + __expf(-c1))) * w[u]; }
        }
        red[(kg * 64 + jl) * 2 + 0] = a0; red[(kg * 64 + jl) * 2 + 1] = a1;
        __syncthreads();
        if (tid < 128) { const int jj = tid & 63, bb = tid >> 6; float s = 0.f;
#pragma unroll
            for (int q = 0; q < 8; ++q) s += red[(q * 64 + jj) * 2 + bb];
            ada[((size_t)l * 2 + bb) * 6144 + jc * 64 + jj] = s + a->b_ada[(size_t)l * 6144 + jc * 64 + jj]; }
        __syncthreads();
    }
    float* scr = (float*)lds + wave * (64 * 33);
    constexpr int I_IN = 16 * (NPROJ / 32), I_OUT = 16 * (D / 32), I_DN = (DFF / 64) * (D / 32);
    constexpr int NITEMS = DEPTH * (I_IN + I_OUT + I_DN);
    for (int it = I.gw; it < NITEMS; it += I.NW) {
        int r = it;
        if (r < DEPTH * I_IN) { const int l = r / I_IN; r %= I_IN; transpose_item(a->w_in + (size_t)l * D * NIN, NIN, D, wt_in + (size_t)l * NPROJ * D, NPROJ / 32, scr, r, lane, [](int p) { return win_src_col(p); }); continue; }
        r -= DEPTH * I_IN;
        if (r < DEPTH * I_OUT) { const int l = r / I_OUT; r %= I_OUT; transpose_item(a->w_out + (size_t)l * D * D, D, D, wt_out + (size_t)l * D * D, D / 32, scr, r, lane, [](int p) { return p; }); continue; }
        r -= DEPTH * I_OUT;
        { const int l = r / I_DN; r %= I_DN; transpose_item(a->w_down + (size_t)l * DFF * D, D, DFF, wt_dn + (size_t)l * D * DFF, D / 32, scr, r, lane, [](int p) { return p; }); }
    }
    {
        half_t* cw = (half_t*)(ws + WS_CW); float* cbias = (float*)(ws + WS_CB);
        for (int it = I.gw; it < DEPTH * 2 * 64; it += I.NW) {
            const int l = it >> 7, kv = (it >> 6) & 1, r = it & 63;
            if (kv == 0) transpose_item<true>(a->cmp_w_k + (size_t)l * 2048 * 64, 64, 2048, cw + (size_t)(l * 2 + 0) * 64 * 2048, 2, scr, r, lane, [](int p) { return rope_perm(p); });
            else transpose_item<false>(a->cmp_w_v + (size_t)l * 2048 * 64, 64, 2048, cw + (size_t)(l * 2 + 1) * 64 * 2048, 2, scr, r, lane, [](int p) { return p; });
        }
        for (int it = I.gw; it < DEPTH * 2; it += I.NW) {
            const int l = it >> 1, kv = it & 1;
            const float* w = (kv == 0 ? a->cmp_w_k : a->cmp_w_v) + (size_t)l * 2048 * 64; const float* pe = (kv == 0 ? a->cmp_pe_k : a->cmp_pe_v) + (size_t)l * 2048;
            const int e = kv == 0 ? rope_perm(lane) : lane; float acc = 0.f;
            for (int k = 0; k < 2048; ++k) acc += pe[k] * w[(size_t)k * 64 + e];
            cbias[(l * 2 + kv) * 64 + lane] = acc;
        }
    }
    for (int idx = I.gtid; idx < M * 32; idx += I.NT) {
        const int mrow = idx >> 5, i = idx & 31;
        const float ang = (float)a->positions[mrow] * a->inv_freq[i];
        const double xd = (double)ang; const double kq = rint(xd * 0.15915494309189535);
        const float rf = (float)fma(-kq, 6.283185307179586, xd);
        cosT[idx] = cosf(rf); sinT[idx] = sinf(rf);
    }
}

__device__ __forceinline__ void phase_p0b(ArgsP a) {
    const Ids I = make_ids(); unsigned char* ws = ws_base(a);
    const float* ada = (const float*)(ws + WS_ADA); half_t* hx = (half_t*)(ws + WS_HX);
    rowwise_phase<false, true, 0, 0>(a->x, nullptr, nullptr, nullptr, nullptr, nullptr, a->norm_w + 0 * D, ada + 1024, ada + 0, hx, I.gw, I.NW, I.lane);
}

__device__ __forceinline__ void phase_inproj(ArgsP a, int layer, unsigned char* lds) {
    unsigned char* ws = ws_base(a);
    pg8::Gemm g{(const half_t*)(ws + WS_HX), (const half_t*)(ws + WS_WT_IN) + (size_t)layer * NPROJ * D, M, NPROJ, D, D};
    pg8::StaticOrder So; So.init(M, NPROJ, (int)gridDim.x, opaque_bid());
    pg8::EpiProj E{(half_t*)(ws + WS_PROJ), (const float*)(ws + WS_COS), (const float*)(ws + WS_SIN), (half_t*)(ws + WS_VT), (half_t*)(ws + WS_KF), ws + WS_KS8, ws + WS_VS8};
    pg8::gemm_phase<pg8::EpiProj>((PG8_LAS unsigned char*)lds, g, So, E);
}

__device__ __forceinline__ void phase_compress(ArgsP a, int layer, unsigned char* lds) {
    const Ids I = make_ids(); unsigned char* ws = ws_base(a);
    const int lane = I.lane;
    const half_t* proj = (const half_t*)(ws + WS_PROJ); half_t* kc = (half_t*)(ws + WS_KC); half_t* vct = (half_t*)(ws + WS_VCT); half_t* wt_gu = (half_t*)(ws + WS_WT_GU);
    {
        const half_t* cw = (const half_t*)(ws + WS_CW) + (size_t)layer * 2 * 64 * 2048; const float* cbias = (const float*)(ws + WS_CB) + layer * 128;
        const int c = lane & 15, g = lane >> 4;
        for (int wu = I.gw - (I.NW - 1024); wu >= 0 && wu < 1024; wu += I.NW) {
            const int kv = wu >> 9, b = (wu >> 8) & 1, nb = (wu >> 2) & 63, et = wu & 3;
            const int nrow = 16 * nb + c;
            const half_t* wrow = cw + ((size_t)kv * 64 + 16 * et + c) * 2048 + 8 * g;
            const half_t* xcol = proj + (size_t)b * S * NPROJ + (4 + kv) * 64 + 8 * g;
            f32x4 acc = {0.f, 0.f, 0.f, 0.f};
#pragma unroll 1
            for (int k8 = 0; k8 < 64; k8 += 8) {
                half8 af[8], bf[8];
#pragma unroll
                for (int u = 0; u < 8; ++u) { const int ks = k8 + u; int tok = 16 * nrow + (ks >> 1); tok = tok < S ? tok : S - 1;
                    af[u] = *(const half8*)(xcol + (size_t)tok * NPROJ + 32 * (ks & 1)); bf[u] = *(const half8*)(wrow + 32 * ks); }
#pragma unroll
                for (int u = 0; u < 8; ++u) acc = MFMA16(af[u], bf[u], acc);
            }
            const float bs = cbias[kv * 64 + 16 * et + c];
#pragma unroll
            for (int r = 0; r < 4; ++r) {
                const int n = 16 * nb + 4 * g + r, e = 16 * et + c;
                const float v = (n == 1023) ? 0.f : acc[r] + bs;
                if (kv == 0) kc[(size_t)b * 65536 + (size_t)(n >> 5) * 2048 + ((((n >> 4) & 1) * 2 + (e >> 5)) * 64 + (n & 15) * 4 + ((e >> 3) & 3)) * 8 + (e & 7)] = (half_t)v;
                else vct[(size_t)b * 65536 + (size_t)(n >> 5) * 2048 + (e * 4 + ((n & 15) >> 2)) * 8 + (n & 3) + 4 * ((n >> 4) & 1)] = (half_t)v;
            }
        }
    }
    float* scr = (float*)lds + I.wave * (64 * 33);
    constexpr int I_G = 16 * (DFF / 32);
    const float* wg = a->w_gate + (size_t)layer * D * DFF; const float* wu_ = a->w_up + (size_t)layer * D * DFF;
    for (int it = I.gw; it < 2 * I_G; it += I.NW) {
        const int up = it >= I_G, r = up ? it - I_G : it, n0 = 32 * (r % (DFF / 32));
        const long dsh = (long)(256 * (n0 >> 7) + (n0 & 127) + 128 * up) - n0;
        transpose_item(up ? wu_ : wg, DFF, D, wt_gu + dsh * D, DFF / 32, scr, r, lane, [](int p) { return p; });
    }
}

__device__ __forceinline__ void phase_attn(ArgsP a, int layer, unsigned char* lds) {
    const Ids I = make_ids(); unsigned char* ws = ws_base(a);
    ACtx X{(const half_t*)(ws + WS_PROJ), (const half_t*)(ws + WS_KC), (const half_t*)(ws + WS_VCT), (const half_t*)(ws + WS_VT), (const half_t*)(ws + WS_KF), (half_t*)(ws + WS_MIX), (float*)(ws + WS_LSE), a->sinks + layer * 6, ws + WS_KS8, ws + WS_VS8};
    float* ldsw = (float*)lds + I.wave * 4288;
    for (int i = 0; i < 2; ++i) {
        const int ua = (i == 0) ? I.gw : (4095 - I.gw);
        if (ua >= 0 && ua < 4096) a_unit(X, ua >> 11, (ua & 2047) * 8, ldsw, I.lane);
    }
    if (I.G == 256) {
        const int bid = I.gw >> 3;
        int start = 0;
        for (int b2 = 0; b2 < bid; ++b2) { const int e2 = 2 * b2 - 255; start += 8 * (3 + (((e2 < 0 ? -e2 : e2) + 32) >> 6)); }
        const int e1 = 2 * bid - 255; const int n = 3 + (((e1 < 0 ? -e1 : e1) + 32) >> 6);
        start += (I.gw & 7) * n;
        for (int k = start; k < start + n; ++k) {
            if (k < 6144) { const int b = k / 3072, rem = k % 3072; b_unit(X, b, rem >> 9, rem & 511, I.lane); }
            else { const int u = k - 6144; const int b = u >> 11, rem = u & 2047; c_unit(X, b, rem >> 10, rem & 1023, I.lane); }
        }
    } else {
        for (int u = I.gw; u < 6144; u += I.NW) { const int b = u / 3072, rem = u % 3072; b_unit(X, b, rem >> 9, rem & 511, I.lane); }
        for (int u = I.gw; u < 4096; u += I.NW) { const int b = u >> 11, rem = u & 2047; c_unit(X, b, rem >> 10, rem & 1023, I.lane); }
    }
}

__device__ __forceinline__ void phase_combine(ArgsP a) {
    const Ids I = make_ids(); unsigned char* ws = ws_base(a);
    const float* lse = (const float*)(ws + WS_LSE); half_t* mix = (half_t*)(ws + WS_MIX);
    for (int idx0 = I.gtid; idx0 < M * 48; idx0 += 4 * I.NT) {
        float l0[4], l1[4], l2[4]; half8 v[4]; bool ok[4];
#pragma unroll
        for (int u = 0; u < 4; ++u) {
            const int idx = idx0 + u * I.NT; ok[u] = idx < M * 48;
            const int ix = ok[u] ? idx : idx0;
            const int c8 = ix & 7, h6 = (ix >> 3) % 6, mrow = ix / 48, hh = h6 & 1;
            l0[u] = lse[(size_t)mrow * 6 + hh]; l1[u] = lse[(size_t)mrow * 6 + 2 + hh]; l2[u] = lse[(size_t)mrow * 6 + 4 + hh];
            v[u] = *(const half8*)(mix + (size_t)mrow * D + (4 + h6) * 64 + c8 * 8);
        }
#pragma unroll
        for (int u = 0; u < 4; ++u) {
            const int idx = idx0 + u * I.NT;
            if (!ok[u]) continue;
            const int c8 = idx & 7, h6 = (idx >> 3) % 6, mrow = idx / 48, gsel = h6 >> 1;
            const float mx = fmaxf(l0[u], fmaxf(l1[u], l2[u]));
            const float e0 = __builtin_amdgcn_exp2f(l0[u] - mx), e1 = __builtin_amdgcn_exp2f(l1[u] - mx), e2 = __builtin_amdgcn_exp2f(l2[u] - mx);
            const float al = (gsel == 0 ? e0 : (gsel == 1 ? e1 : e2)) / (e0 + e1 + e2);
            half8 w = v[u];
#pragma unroll
            for (int j = 0; j < 8; ++j) w[j] = (half_t)((float)w[j] * al);
            *(half8*)(mix + (size_t)mrow * D + (4 + h6) * 64 + c8 * 8) = w;
        }
    }
}

__device__ __forceinline__ void phase_outproj(ArgsP a, int layer, unsigned char* lds) {
    unsigned char* ws = ws_base(a);
    pg8::Gemm g{(const half_t*)(ws + WS_MIX), (const half_t*)(ws + WS_WT_OUT) + (size_t)layer * D * D, M, D, D, D};
    pg8::StaticOrder So; So.init(M, D, (int)gridDim.x, opaque_bid());
    pg8::EpiF16 E{(half_t*)(ws + WS_HX), D};
    pg8::gemm_phase<pg8::EpiF16>((PG8_LAS unsigned char*)lds, g, So, E);
}

__device__ __forceinline__ void phase_r1(ArgsP a, int layer) {
    const Ids I = make_ids(); unsigned char* ws = ws_base(a);
    const float* adaL = (const float*)(ws + WS_ADA) + (size_t)layer * 2 * 6144; const float* nw = a->norm_w + (size_t)layer * 4 * D; half_t* hx = (half_t*)(ws + WS_HX);
    half_t* x16 = (half_t*)(ws + WS_X16);
    if (layer == 0) rowwise_phase<true, true, 0, 1>(a->x, x16, nullptr, hx, nw + 1 * D, adaL + 2048, nw + 2 * D, adaL + 4096, adaL + 3072, hx, I.gw, I.NW, I.lane);
    else rowwise_phase<true, true, 1, 1>(nullptr, x16, nullptr, hx, nw + 1 * D, adaL + 2048, nw + 2 * D, adaL + 4096, adaL + 3072, hx, I.gw, I.NW, I.lane);
}

__device__ __forceinline__ void phase_gateup(ArgsP a, int layer, unsigned char* lds) {
    unsigned char* ws = ws_base(a);
    pg8::Gemm g{(const half_t*)(ws + WS_HX), (const half_t*)(ws + WS_WT_GU), M, NGU, D, D};
    pg8::StaticOrder So; So.init(M, NGU, (int)gridDim.x, opaque_bid());
    pg8::EpiAct E{(half_t*)(ws + WS_ACT), a->conv_w + (size_t)layer * 3 * DFF, a->conv_b + (size_t)layer * DFF, (float*)(ws + WS_GB), (float*)(ws + WS_UB)};
    pg8::gemm_phase<pg8::EpiAct>((PG8_LAS unsigned char*)lds, g, So, E);
}

__device__ __forceinline__ void phase_act(ArgsP a, int layer) {
    const Ids I = make_ids(); unsigned char* ws = ws_base(a);
    half_t* act = (half_t*)(ws + WS_ACT); const float* gb = (const float*)(ws + WS_GB); const float* ub = (const float*)(ws + WS_UB);
    const float* cw = a->conv_w + (size_t)layer * 3 * DFF; const float* cb = a->conv_b + (size_t)layer * DFF;
    for (int idx0 = I.gtid; idx0 < 128 * 2 * DFF; idx0 += 4 * I.NT) {
        float g0[4], uu[4], gm1[4], gm2[4], gr0[4], c0[4], c1[4], c2[4], cbv[4]; bool ok[4];
#pragma unroll
        for (int u = 0; u < 4; ++u) {
            const int idx = idx0 + u * I.NT; ok[u] = idx < 128 * 2 * DFF;
            const int ix = ok[u] ? idx : idx0;
            const int pm = ix / (2 * DFF), rem = ix % (2 * DFF), row = rem / DFF, j = rem % DFF;
            g0[u] = gb[((size_t)pm * 4 + row) * DFF + j]; uu[u] = ub[((size_t)pm * 2 + row) * DFF + j];
            gm1[u] = 0.f; gm2[u] = 0.f;
            if ((pm & 63) != 0) { gm1[u] = gb[((size_t)(pm - 1) * 4 + 3) * DFF + j]; gm2[u] = gb[((size_t)(pm - 1) * 4 + 2) * DFF + j]; }
            gr0[u] = gb[((size_t)pm * 4 + 0) * DFF + j];
            c0[u] = cw[j]; c1[u] = cw[DFF + j]; c2[u] = cw[2 * DFF + j]; cbv[u] = cb[j];
        }
#pragma unroll
        for (int u = 0; u < 4; ++u) {
            const int idx = idx0 + u * I.NT;
            if (!ok[u]) continue;
            const int pm = idx / (2 * DFF), rem = idx % (2 * DFF), row = rem / DFF, j = rem % DFF;
            const float g1 = row == 0 ? gm1[u] : gr0[u], g2 = row == 0 ? gm2[u] : gm1[u];
            const float v = c0[u] * g2 + c1[u] * g1 + c2[u] * g0[u] + cbv[u];
            act[((size_t)pm * 256 + row) * DFF + j] = (half_t)(gelu_tanh(v) * uu[u]);
        }
    }
}

__device__ __forceinline__ void phase_down(ArgsP a, int layer, unsigned char* lds) {
    unsigned char* ws = ws_base(a);
    pg8::Gemm g{(const half_t*)(ws + WS_ACT), (const half_t*)(ws + WS_WT_DN) + (size_t)layer * D * DFF, M, D, DFF, DFF};
    pg8::StaticOrder So; So.init(M, D, (int)gridDim.x, opaque_bid());
    pg8::EpiF16 E{(half_t*)(ws + WS_HX), D};
    pg8::gemm_phase<pg8::EpiF16>((PG8_LAS unsigned char*)lds, g, So, E);
}

__device__ __forceinline__ void phase_r2(ArgsP a, int layer) {
    const Ids I = make_ids(); unsigned char* ws = ws_base(a);
    const float* ada = (const float*)(ws + WS_ADA); const float* adaL = ada + (size_t)layer * 2 * 6144; const float* nw = a->norm_w + (size_t)layer * 4 * D; half_t* hx = (half_t*)(ws + WS_HX);
    if (layer + 1 < DEPTH) {
        const float* adaN = ada + (size_t)(layer + 1) * 2 * 6144;
        rowwise_phase<true, true, 1, 1>(nullptr, (half_t*)(ws + WS_X16), nullptr, hx, nw + 3 * D, adaL + 5120, a->norm_w + (size_t)(layer + 1) * 4 * D, adaN + 1024, adaN + 0, hx, I.gw, I.NW, I.lane);
    } else {
        rowwise_phase<true, false, 1, 2>(nullptr, (half_t*)(ws + WS_X16), a->out, hx, nw + 3 * D, adaL + 5120, nullptr, nullptr, nullptr, nullptr, I.gw, I.NW, I.lane);
    }
}

#define LAS __attribute__((address_space(3)))
#define XB_TMO      128
#define XB_XCNT(j)  (256  + 64 * (j))
#define XB_XSUB(j)  (1280 + 64 * (j))
#define XB_XGEN(j)  (2304 + 64 * (j))
#define XB_TOP      3328
#define XB_TOPGEN   3392
#define XCD_BAR_WORDS 3456
#define XB_SPIN_CAP (1u << 22)
__device__ __forceinline__ unsigned xb_ld(unsigned* p)              { return __hip_atomic_load(p, __ATOMIC_RELAXED, __HIP_MEMORY_SCOPE_AGENT); }
__device__ __forceinline__ unsigned xb_add(unsigned* p, unsigned v) { return __hip_atomic_fetch_add(p, v, __ATOMIC_RELAXED, __HIP_MEMORY_SCOPE_AGENT); }
__device__ __forceinline__ unsigned xb_xcc_id() { return (unsigned)__builtin_amdgcn_s_getreg((3 << 11) | 20) & 0xFu; }
#define XB_SPIN(cond, bar) do { unsigned _sp = 0; while (cond) { __builtin_amdgcn_s_sleep(1); \
    if ((++_sp & 255u) == 0u) { if (xb_ld(&(bar)[XB_TMO])) break; if (_sp > XB_SPIN_CAP) { atomicAdd(&(bar)[XB_TMO], 1u); break; } } } } while (0)
__device__ __forceinline__ void xcd_barrier_complete(unsigned* bar, unsigned x, unsigned& nloc, unsigned& nx) {
    const unsigned G = gridDim.x * gridDim.y * gridDim.z;
    unsigned sum, cnt, mine, sp = 0u;
    for (;;) {
        sum = 0u; cnt = 0u; mine = 0u;
#pragma unroll
        for (unsigned j = 0; j < 16; ++j) { const unsigned c = xb_ld(&bar[XB_XCNT(j)]); sum += c; cnt += (c > 0u) ? 1u : 0u; mine = (j == x) ? c : mine; }
        if (sum == G) break;
        __builtin_amdgcn_s_sleep(1);
        if ((++sp & 255u) == 0u) { if (xb_ld(&bar[XB_TMO])) break; if (sp > XB_SPIN_CAP) { atomicAdd(&bar[XB_TMO], 1u); break; } }
    }
    nloc = mine > 0u ? mine : 1u; nx = cnt > 0u ? cnt : 1u;
}
__device__ __forceinline__ void xcd_barrier(unsigned* bar, volatile LAS unsigned* st) {
    asm volatile("s_waitcnt vmcnt(0)" ::: "memory");
    __syncthreads();
    if (threadIdx.x == 0) {
        const unsigned x = xb_xcc_id();
        __builtin_amdgcn_s_waitcnt(0);
        unsigned nloc = st[0], nx = st[1];
        if (nloc == 0u) { xcd_barrier_complete(bar, x, nloc, nx); st[0] = nloc; st[1] = nx; }
        const unsigned old = xb_add(&bar[XB_XSUB(x)], 1u);
        const unsigned gen = old / nloc;
        if (old + 1u == (gen + 1u) * nloc) {
            __builtin_amdgcn_fence(__ATOMIC_RELEASE, "agent");
            asm volatile("s_waitcnt vmcnt(0)" ::: "memory");
            const unsigned og = xb_add(&bar[XB_TOP], 1u);
            const unsigned tg = og / nx;
            if (og + 1u == (tg + 1u) * nx) xb_add(&bar[XB_TOPGEN], 1u);
            else XB_SPIN(xb_ld(&bar[XB_TOPGEN]) == tg, bar);
            __builtin_amdgcn_fence(__ATOMIC_ACQUIRE, "agent");
            xb_add(&bar[XB_XGEN(x)], 1u);
            asm volatile("s_waitcnt vmcnt(0)" ::: "memory");
        } else {
            XB_SPIN(xb_ld(&bar[XB_XGEN(x)]) == gen, bar);
            __builtin_amdgcn_fence(__ATOMIC_ACQUIRE, "agent");
            asm volatile("s_waitcnt vmcnt(0)" ::: "memory");
        }
    }
    __syncthreads();
}

__global__ void __launch_bounds__(NTHREADS, 2) trunk_fwd(Args a) {
    extern __shared__ __attribute__((aligned(16))) unsigned char lds[];
    cg::grid_group grid = cg::this_grid();
    volatile LAS unsigned* bst = (volatile LAS unsigned*)((LAS unsigned char*)lds + (LDS_BYTES - 64));
    if (threadIdx.x < 2) bst[threadIdx.x] = 0u;
    if (blockIdx.x == 0) { unsigned* bw = (unsigned*)(a.ws + WS_BAR); for (int i = threadIdx.x; i < XCD_BAR_WORDS; i += NTHREADS) bw[i] = 0u; }
    if (PH & 1) phase_p0a(largs(), lds);
    if (REP & 1) { phase_p0a(largs(), lds); }
    grid.sync();
    if (threadIdx.x == 0) (void)xb_add((unsigned*)(largs()->ws + WS_BAR) + XB_XCNT(xb_xcc_id()), 1u);
#define GSYNC() xcd_barrier((unsigned*)(largs()->ws + WS_BAR), bst)
    if (PH & 2) phase_p0b(largs());
    GSYNC();
    for (int layer = 0; layer < DEPTH; ++layer) {
        if (PH & 4) phase_inproj(largs(), layer, lds);
        GSYNC();
        if (REP & 4) { phase_inproj(largs(), layer, lds); GSYNC(); }
        if (PH & 8) phase_compress(largs(), layer, lds);
        GSYNC();
        if (REP & 8) { phase_compress(largs(), layer, lds); GSYNC(); }
        if (PH & 16) phase_attn(largs(), layer, lds);
        GSYNC();
        if (REP & 16) { phase_attn(largs(), layer, lds); GSYNC(); }
        if (PH & 32) phase_combine(largs());
        GSYNC();
        if (PH & 64) phase_outproj(largs(), layer, lds);
        GSYNC();
        if (REP & 64) { phase_outproj(largs(), layer, lds); GSYNC(); }
        if (PH & 128) phase_r1(largs(), layer);
        GSYNC();
        if (PH & 256) phase_gateup(largs(), layer, lds);
        GSYNC();
        if (REP & 256) { phase_gateup(largs(), layer, lds); GSYNC(); }
        if (PH & 512) phase_act(largs(), layer);
        GSYNC();
        if (PH & 1024) phase_down(largs(), layer, lds);
        GSYNC();
        if (REP & 1024) { phase_down(largs(), layer, lds); GSYNC(); }
        if (PH & 2048) phase_r2(largs(), layer);
        if (layer + 1 < DEPTH) GSYNC();
    }
}

extern "C" void kernel_launch(void* const* d_in, const int* in_sizes, int n_in, void* d_out, int out_size, void* d_ws, size_t ws_size, hipStream_t stream) {
    static int grid = 0;
    if (grid == 0) {
        int dev = 0, cus = 0, per_cu = 0;
        if (n_in != 18 || ws_size < WS_END) { fprintf(stderr, "kernel_launch: unexpected inputs (n_in %d, ws %zu)\n", n_in, ws_size); grid = -1; return; }
        hipGetDevice(&dev);
        hipDeviceGetAttribute(&cus, hipDeviceAttributeMultiprocessorCount, dev);
        hipFuncSetAttribute((const void*)trunk_fwd, hipFuncAttributeMaxDynamicSharedMemorySize, LDS_BYTES);
        hipOccupancyMaxActiveBlocksPerMultiprocessor(&per_cu, (const void*)trunk_fwd, NTHREADS, LDS_BYTES);
        if (per_cu < 1) per_cu = 1;
        grid = cus * per_cu;
        (void)hipGetLastError();
    }
    if (grid < 0) return;
    Args a{};
    a.x = (const float*)d_in[0]; a.c = (const float*)d_in[1]; a.positions = (const int*)d_in[2]; a.w_in = (const float*)d_in[3]; a.w_out = (const float*)d_in[4];
    a.w_ada = (const float*)d_in[5]; a.b_ada = (const float*)d_in[6]; a.norm_w = (const float*)d_in[7]; a.cmp_w_k = (const float*)d_in[8]; a.cmp_w_v = (const float*)d_in[9];
    a.cmp_pe_k = (const float*)d_in[10]; a.cmp_pe_v = (const float*)d_in[11]; a.sinks = (const float*)d_in[12]; a.w_gate = (const float*)d_in[13]; a.w_up = (const float*)d_in[14];
    a.conv_w = (const float*)d_in[15]; a.conv_b = (const float*)d_in[16]; a.w_down = (const float*)d_in[17];
    a.out = (float*)d_out; a.ws = (unsigned char*)d_ws;
    for (int i = 0; i < 32; ++i) a.inv_freq[i] = (float)pow(10000.0, -(double)i / 32.0);
    void* args[] = {&a};
    hipError_t e = hipLaunchCooperativeKernel((const void*)trunk_fwd, dim3(grid), dim3(NTHREADS), args, LDS_BYTES, stream);
    if (e != hipSuccess) fprintf(stderr, "cooperative launch failed: %s (grid %d)\n", hipGetErrorString(e), grid);
}
```

```cpp
#include <hip/hip_runtime.h>
#include <hip/hip_cooperative_groups.h>
#include <cstdio>
#include <cstdint>
#include <cmath>
namespace cg = cooperative_groups;

typedef _Float16 half_t;
typedef _Float16 half8 __attribute__((ext_vector_type(8)));
typedef _Float16 half4 __attribute__((ext_vector_type(4)));
typedef _Float16 half2v __attribute__((ext_vector_type(2)));
typedef float f32x4 __attribute__((ext_vector_type(4)));
typedef unsigned u32x4 __attribute__((ext_vector_type(4)));
typedef unsigned u32x2 __attribute__((ext_vector_type(2)));

constexpr int D = 1024, NBATCH = 2, S = 16384, M = NBATCH * S, DEPTH = 4, DFF = 2816;
constexpr int NPROJ = 2560, NIN = 2444, NGU = 2 * DFF;
constexpr float RMS_EPS = 1e-6f;
constexpr float QSCALE = 0.125f * 1.4426950408889634f;
constexpr float LOG2E = 1.4426950408889634f;
constexpr int NWAVES = 8, NTHREADS = 512;

constexpr size_t MiB = 1u << 20;
constexpr size_t WS_WT_IN = 0;
constexpr size_t WS_WT_OUT = 20 * MiB;
constexpr size_t WS_WT_DN = 28 * MiB;
constexpr size_t WS_WT_GU = 50 * MiB;
constexpr size_t WS_COS = 61 * MiB;
constexpr size_t WS_SIN = 65 * MiB;
constexpr size_t WS_ADA = 69 * MiB;
constexpr size_t WS_KC = 70 * MiB;
constexpr size_t WS_VCT = 70 * MiB + 512 * 1024;
constexpr size_t WS_LSE = 71 * MiB;
constexpr size_t WS_HX = 72 * MiB;
constexpr size_t WS_BIG = 136 * MiB;
constexpr size_t WS_PROJ = WS_BIG;
constexpr size_t WS_MIX = WS_BIG + 160 * MiB;
constexpr size_t WS_VT = WS_BIG + 224 * MiB;
constexpr size_t WS_KF = WS_BIG + 264 * MiB;
constexpr size_t WS_ACT = WS_BIG;
constexpr size_t WS_GB = WS_BIG + 176 * MiB;
constexpr size_t WS_UB = WS_BIG + 182 * MiB;
constexpr size_t WS_X16 = 440 * MiB;
constexpr size_t WS_CW = 504 * MiB;
constexpr size_t WS_CB = WS_ADA + 256 * 1024;
constexpr size_t WS_BAR = 506 * MiB;
constexpr size_t WS_KS8 = 507 * MiB;
constexpr size_t WS_VS8 = 509 * MiB;
constexpr size_t WS_END = 511 * MiB;

constexpr int LDS_BYTES = 151552;

namespace pg8 {
#define PG8_LAS __attribute__((address_space(3)))
constexpr int BM = 256, BK = 64, HALF = 128, HTB = HALF * BK * 2, STAGE_BYTES = 8 * HTB, NXCD = 8, WGM = 8;

__host__ __device__ __forceinline__ int lds_byte(int r, int c) { const int st = (r >> 4) * 2 + (c >> 5), rr = r & 15, cc = c & 31, ob = rr * 64 + cc * 2; return st * 1024 + (ob ^ (((ob >> 9) & 1) << 5)); }
__host__ __device__ __forceinline__ void stage_rc(int b, int& R, int& C) { const int st = b / 1024, sb = b % 1024, swz = sb ^ (((sb >> 9) & 1) << 5); R = (st >> 1) * 16 + swz / 64; C = (st & 1) * 32 + (swz % 64) / 2; }
__host__ __device__ __forceinline__ int perm32(int rho) { const int n = rho >> 4, i = rho & 15; return 8 * (i >> 2) + 4 * n + (i & 3); }

struct Unit { int pm, pn; };
struct Gemm { const half_t* A; const half_t* Bt; int M, N, K, lda; };

struct StaticOrder {
    int nM, nN, nwg, G, c;
    __host__ __device__ void init(int M_, int N_, int G_, int c_) { nM = M_ / BM; nN = N_ / BM; nwg = nM * nN; G = G_; c = c_; }
    __host__ __device__ bool next(int i, Unit& u) const {
        const long L = (long)i * G + c; if (L >= nwg) return false;
        int wgid = (int)L; { const int q = nwg / NXCD, r = nwg % NXCD, xcd = wgid % NXCD, off = wgid / NXCD; wgid = (xcd < r ? xcd * (q + 1) : r * (q + 1) + (xcd - r) * q) + off; }
        const int nig = WGM * nN, gid = wgid / nig, fm = gid * WGM, gsz = (nM - fm) < WGM ? (nM - fm) : WGM;
        u.pm = fm + ((wgid % nig) % gsz); u.pn = (wgid % nig) / gsz; return true;
    }
};

__device__ __forceinline__ unsigned pkh(float lo, float hi) { half2v v = {(half_t)lo, (half_t)hi}; return __builtin_bit_cast(unsigned, v); }

struct EpiF16 {
    static constexpr bool PERM = true;
    half_t* O; int ldc;
    __device__ __forceinline__ void operator()(const f32x4 (&acc)[2][2][4][2], const Unit& u, int wr, int wc, int fr, int fq, PG8_LAS unsigned char*) const {
        const int row0 = u.pm * BM + wr * 64 + fr; const int col0 = u.pn * BM + wc * 32 + 8 * fq;
#pragma unroll
        for (int ai = 0; ai < 2; ++ai)
#pragma unroll
            for (int m = 0; m < 4; ++m) { half_t* rowp = O + (size_t)(row0 + ai * HALF + m * 16) * ldc + col0;
#pragma unroll
                for (int bj = 0; bj < 2; ++bj) { const f32x4 v0 = acc[ai][bj][m][0], v1 = acc[ai][bj][m][1];
                    u32x4 w; w.x = pkh(v0[0], v0[1]); w.y = pkh(v0[2], v0[3]); w.z = pkh(v1[0], v1[1]); w.w = pkh(v1[2], v1[3]);
                    *(u32x4*)(rowp + bj * HALF) = w; } }
    }
};

struct EpiProj {
    static constexpr bool PERM = true;
    half_t* P; const float* cosT; const float* sinT; half_t* vt; half_t* kf; unsigned char* ks8; unsigned char* vs8;
    __device__ __forceinline__ void operator()(const f32x4 (&acc)[2][2][4][2], const Unit& u, int wr, int wc, int fr, int fq, PG8_LAS unsigned char* lds) const {
        const int row0 = u.pm * BM + wr * 64 + fr; const int gsub = wc & 1;
        bool isq[2], isk[2], isg[2]; int vi[2], ki[2], col0[2];
#pragma unroll
        for (int bj = 0; bj < 2; ++bj) {
            const int slot = u.pn * 4 + bj * 2 + (wc >> 1);
            isq[bj] = (slot < 4) || (slot >= 10 && slot < 16) || (slot >= 28 && slot < 34);
            isk[bj] = slot == 4 || slot == 6 || slot == 8 || (slot >= 16 && slot < 22) || slot == 34 || slot == 35;
            vi[bj] = -1;
            if (slot == 7) vi[bj] = 0; else if (slot == 9) vi[bj] = 1; else if (slot >= 22 && slot < 28) vi[bj] = 2 + (slot - 22); else if (slot == 36 || slot == 37) vi[bj] = 8 + (slot - 36);
            ki[bj] = -1;
            if (slot == 6) ki[bj] = 0; else if (slot == 8) ki[bj] = 1; else if (slot >= 16 && slot < 22) ki[bj] = 2 + (slot - 16); else if (slot == 34 || slot == 35) ki[bj] = 8 + (slot - 34);
            isg[bj] = slot == 38;
            col0[bj] = slot * 64 + gsub * 32 + 8 * fq;
        }
        const bool anyrope = isq[0] || isk[0] || isq[1] || isk[1];
#pragma unroll
        for (int ai = 0; ai < 2; ++ai)
#pragma unroll
            for (int m = 0; m < 4; ++m) {
                const int row = row0 + ai * HALF + m * 16;
                f32x4 cs = {1.f, 1.f, 1.f, 1.f}, sn = {0.f, 0.f, 0.f, 0.f};
                if (anyrope) { cs = *(const f32x4*)(cosT + (size_t)row * 32 + 16 * gsub + 4 * fq); sn = *(const f32x4*)(sinT + (size_t)row * 32 + 16 * gsub + 4 * fq); }
#pragma unroll
                for (int bj = 0; bj < 2; ++bj) {
                    f32x4 v0 = acc[ai][bj][m][0], v1 = acc[ai][bj][m][1];
                    if (isq[bj] || isk[bj]) {
                        const f32x4 o0 = v0 * cs - v1 * sn, o1 = v1 * cs + v0 * sn;
                        v0 = o0; v1 = o1;
                        if (isq[bj]) { v0 = v0 * QSCALE; v1 = v1 * QSCALE; }
                    } else if (isg[bj]) {
#pragma unroll
                        for (int j = 0; j < 4; ++j) { v0[j] = 1.f / (1.f + __expf(-v0[j])); v1[j] = 1.f / (1.f + __expf(-v1[j])); }
                    }
                    u32x4 w; w.x = pkh(v0[0], v0[1]); w.y = pkh(v0[2], v0[3]); w.z = pkh(v1[0], v1[1]); w.w = pkh(v1[2], v1[3]);
                    if (vi[bj] < 0 && ki[bj] < 0) *(u32x4*)(P + (size_t)row * NPROJ + col0[bj]) = w;
                    else {
                        const int b = row >> 14, tl = row & (S - 1);
                        const int xi = vi[bj] >= 0 ? vi[bj] : ki[bj];
                        int pos = tl;
                        if (xi >= 2 && xi < 8) { const int sh = 2 * ((xi - 2) >> 1); pos = ((tl & ((1 << sh) - 1)) << (14 - sh)) + (tl >> sh); }
                        const size_t blk = ((size_t)(xi * 2 + b) * (S / 32) + (pos >> 5)) * 2048;
                        if (ki[bj] == 0) {
                            u32x2 w8; int p0 = __builtin_amdgcn_cvt_pk_fp8_f32(v0[0], v0[1], 0, false); p0 = __builtin_amdgcn_cvt_pk_fp8_f32(v0[2], v0[3], p0, true);
                            int p1 = __builtin_amdgcn_cvt_pk_fp8_f32(v1[0], v1[1], 0, false); p1 = __builtin_amdgcn_cvt_pk_fp8_f32(v1[2], v1[3], p1, true);
                            w8.x = (unsigned)p0; w8.y = (unsigned)p1;
                            *(u32x2*)(ks8 + ((size_t)b * (S / 32) + (pos >> 5)) * 2048 + ((((pos >> 4) & 1) * 2 + gsub) * 64 + (pos & 15) * 4 + fq) * 8) = w8;
                        } else if (ki[bj] >= 0) {
                            *(u32x4*)(kf + blk + ((((pos >> 4) & 1) * 2 + gsub) * 64 + (pos & 15) * 4 + fq) * 8) = w;
                        } else if (xi == 4 || xi == 5) {
                            half_t* vb = vt + blk + ((gsub * 32 + 8 * fq) * 4 + ((pos & 15) >> 2)) * 8 + (pos & 3) + 4 * ((pos >> 4) & 1);
#pragma unroll
                            for (int j = 0; j < 4; ++j) { vb[j * 32] = (half_t)v0[j]; vb[(4 + j) * 32] = (half_t)v1[j]; }
                        }
                    }
                }
            }
#pragma unroll
        for (int bj = 0; bj < 2; ++bj) {
            const int xi = vi[bj];
            if (xi < 0 || xi == 4 || xi == 5) continue;
            const int lane = fq * 16 + fr, wid = wr * 4 + wc;
            if (xi == 6 || xi == 7) {
#pragma unroll
                for (int ai = 0; ai < 2; ++ai) {
                    const int row = row0 + ai * HALF, b = row >> 14, tl = row & (S - 1);
                    const int p = ((tl & 15) << 10) + (tl >> 4);
                    half_t* vb = vt + ((size_t)(xi * 2 + b) * (S / 32) + (p >> 5)) * 2048 + ((gsub * 32 + 8 * fq) * 4 + ((p & 15) >> 2)) * 8 + 4 * ((p >> 4) & 1);
#pragma unroll
                    for (int j = 0; j < 8; ++j) { u32x2 w; w.x = pkh(acc[ai][bj][0][j >> 2][j & 3], acc[ai][bj][1][j >> 2][j & 3]); w.y = pkh(acc[ai][bj][2][j >> 2][j & 3], acc[ai][bj][3][j >> 2][j & 3]); *(u32x2*)(vb + j * 32) = w; }
                }
            } else {
                PG8_LAS half_t* L = (PG8_LAS half_t*)(lds + STAGE_BYTES) + wid * 1024;
                if (xi == 0) {
                    PG8_LAS unsigned char* L8 = (PG8_LAS unsigned char*)L;
#pragma unroll
                    for (int ai = 0; ai < 2; ++ai)
#pragma unroll
                        for (int mp = 0; mp < 2; ++mp) {
#pragma unroll
                            for (int mm = 0; mm < 2; ++mm)
#pragma unroll
                                for (int j = 0; j < 8; ++j) { const float x = acc[ai][bj][2 * mp + mm][j >> 2][j & 3]; L8[((8 * fq + j) * 4 + (fr >> 2)) * 8 + (fr & 3) + 4 * mm] = (unsigned char)(__builtin_amdgcn_cvt_pk_fp8_f32(x, x, 0, false) & 0xff); }
                            asm volatile("s_waitcnt lgkmcnt(0)" ::: "memory"); __builtin_amdgcn_wave_barrier();
                            const int rowb_ = u.pm * BM + ai * HALF + wr * 64 + 32 * mp, b = rowb_ >> 14, tl = rowb_ & (S - 1);
                            unsigned char* vb = vs8 + ((size_t)b * (S / 32) + (tl >> 5)) * 2048 + (size_t)gsub * 1024;
#pragma unroll
                            for (int t = 0; t < 2; ++t) { const int v = lane + 64 * t; const u32x2 w = *(PG8_LAS u32x2*)(L8 + v * 8); *(u32x2*)(vb + v * 8) = w; }
                            asm volatile("s_waitcnt lgkmcnt(0)" ::: "memory"); __builtin_amdgcn_wave_barrier();
                        }
                    continue;
                }
#pragma unroll
                for (int ai = 0; ai < 2; ++ai)
#pragma unroll
                    for (int mp = 0; mp < 2; ++mp) {
#pragma unroll
                        for (int mm = 0; mm < 2; ++mm)
#pragma unroll
                            for (int j = 0; j < 8; ++j) L[((8 * fq + j) * 4 + (fr >> 2)) * 8 + (fr & 3) + 4 * mm] = (half_t)acc[ai][bj][2 * mp + mm][j >> 2][j & 3];
                        asm volatile("s_waitcnt lgkmcnt(0)" ::: "memory"); __builtin_amdgcn_wave_barrier();
                        const int rowb_ = u.pm * BM + ai * HALF + wr * 64 + 32 * mp, b = rowb_ >> 14, tl = rowb_ & (S - 1);
                        half_t* vb = vt + ((size_t)(xi * 2 + b) * (S / 32) + (tl >> 5)) * 2048 + (size_t)gsub * 1024;
#pragma unroll
                        for (int t = 0; t < 2; ++t) { const int v = lane + 64 * t; const u32x4 w = *(PG8_LAS u32x4*)(L + v * 8); *(u32x4*)(vb + v * 8) = w; }
                        asm volatile("s_waitcnt lgkmcnt(0)" ::: "memory"); __builtin_amdgcn_wave_barrier();
                    }
            }
        }
    }
};

__device__ __forceinline__ float gelu_tanh_f(float v) {
    const float z = 0.7978845608028654f * (v + 0.044715f * v * v * v);
    const float t = __builtin_amdgcn_exp2f(z * 2.8853900817779268f);
    return v * (1.f - __builtin_amdgcn_rcpf(t + 1.f));
}
struct EpiAct {
    static constexpr bool PERM = true;
    half_t* act; const float* cw; const float* cb; float* gb; float* ub;
    __device__ __forceinline__ void operator()(const f32x4 (&acc)[2][2][4][2], const Unit& u, int wr, int wc, int fr, int fq, PG8_LAS unsigned char* lds) const {
        PG8_LAS float* halo = (PG8_LAS float*)(lds + STAGE_BYTES);
        const int lane = fq * 16 + fr;
        const int j0 = u.pn * 128 + wc * 32 + 8 * fq;
#pragma unroll
        for (int ai = 0; ai < 2; ++ai)
            if (fr >= 14) { PG8_LAS float* h = halo + ((((ai * 2 + wr) * 4 + wc) * 2 + (fr - 14)) * 32 + fq * 8);
                *(PG8_LAS f32x4*)h = acc[ai][0][3][0]; *(PG8_LAS f32x4*)(h + 4) = acc[ai][0][3][1]; }
        asm volatile("s_waitcnt lgkmcnt(0)" ::: "memory"); __builtin_amdgcn_s_barrier(); asm volatile("" ::: "memory");
        float w0[8], w1[8], w2[8], bb[8];
        { const f32x4 a0 = *(const f32x4*)(cw + j0), a1 = *(const f32x4*)(cw + j0 + 4), b0 = *(const f32x4*)(cw + DFF + j0), b1 = *(const f32x4*)(cw + DFF + j0 + 4);
          const f32x4 c0 = *(const f32x4*)(cw + 2 * DFF + j0), c1 = *(const f32x4*)(cw + 2 * DFF + j0 + 4), d0 = *(const f32x4*)(cb + j0), d1 = *(const f32x4*)(cb + j0 + 4);
#pragma unroll
          for (int j = 0; j < 4; ++j) { w0[j] = a0[j]; w0[4 + j] = a1[j]; w1[j] = b0[j]; w1[4 + j] = b1[j]; w2[j] = c0[j]; w2[4 + j] = c1[j]; bb[j] = d0[j]; bb[4 + j] = d1[j]; } }
#pragma unroll
        for (int ai = 0; ai < 2; ++ai) {
            const int G = ai * 2 + wr;
            float p1[8], p2[8];
            if (G > 0) {
                PG8_LAS float* h = halo + ((((G - 1) * 4 + wc) * 2) * 32 + fq * 8);
                const f32x4 r62a = *(PG8_LAS f32x4*)h, r62b = *(PG8_LAS f32x4*)(h + 4), r63a = *(PG8_LAS f32x4*)(h + 32), r63b = *(PG8_LAS f32x4*)(h + 36);
#pragma unroll
                for (int j = 0; j < 4; ++j) { p1[j] = r63a[j]; p1[4 + j] = r63b[j]; p2[j] = fr == 0 ? r62a[j] : r63a[j]; p2[4 + j] = fr == 0 ? r62b[j] : r63b[j]; }
            } else {
#pragma unroll
                for (int j = 0; j < 8; ++j) { p1[j] = 0.f; p2[j] = 0.f; }
            }
#pragma unroll
            for (int m = 0; m < 4; ++m) {
                float gv[8], uv[8];
#pragma unroll
                for (int j = 0; j < 4; ++j) { gv[j] = acc[ai][0][m][0][j]; gv[4 + j] = acc[ai][0][m][1][j]; uv[j] = acc[ai][1][m][0][j]; uv[4 + j] = acc[ai][1][m][1][j]; }
                float o8[8];
#pragma unroll
                for (int j = 0; j < 8; ++j) {
                    const float r1 = __builtin_bit_cast(float, __builtin_amdgcn_update_dpp(0, __builtin_bit_cast(int, gv[j]), 0x121, 0xf, 0xf, false));
                    const float r2 = __builtin_bit_cast(float, __builtin_amdgcn_update_dpp(0, __builtin_bit_cast(int, gv[j]), 0x122, 0xf, 0xf, false));
                    const float g1 = fr >= 1 ? r1 : p1[j], g2 = fr >= 2 ? r2 : p2[j];
                    o8[j] = gelu_tanh_f(w0[j] * g2 + w1[j] * g1 + w2[j] * gv[j] + bb[j]) * uv[j];
                    p1[j] = r1; p2[j] = r2;
                }
                const int row = u.pm * BM + ai * HALF + wr * 64 + m * 16 + fr;
                const bool first2 = (G == 0 && m == 0 && fr < 2), last2 = (G == 3 && m == 3 && fr >= 14);
                if (!first2) { u32x4 w; w.x = pkh(o8[0], o8[1]); w.y = pkh(o8[2], o8[3]); w.z = pkh(o8[4], o8[5]); w.w = pkh(o8[6], o8[7]); *(u32x4*)(act + (size_t)row * DFF + j0) = w; }
                if (first2 || last2) {
                    float* gp = gb + ((size_t)u.pm * 4 + (first2 ? fr : 2 + fr - 14)) * DFF + j0;
                    *(f32x4*)gp = (f32x4){gv[0], gv[1], gv[2], gv[3]}; *(f32x4*)(gp + 4) = (f32x4){gv[4], gv[5], gv[6], gv[7]};
                    if (first2) { float* up = ub + ((size_t)u.pm * 2 + fr) * DFF + j0; *(f32x4*)up = (f32x4){uv[0], uv[1], uv[2], uv[3]}; *(f32x4*)(up + 4) = (f32x4){uv[4], uv[5], uv[6], uv[7]}; }
                }
            }
        }
    }
};

template <class Epi>
__device__ __forceinline__ void gemm_phase(PG8_LAS unsigned char* lds, const Gemm g, const StaticOrder& S_, const Epi& E) {
    int tid_ = threadIdx.x; asm volatile("" : "+v"(tid_));
    const int tid = tid_, wid = __builtin_amdgcn_readfirstlane(tid >> 6), lane = tid & 63, wr = wid >> 2, wc = wid & 3, fr = lane & 15, fq = lane >> 4;
    const int K = g.K, nt = K / BK, lda = g.lda;
    unsigned voffA[2], voffB[2];
#pragma unroll
    for (int i = 0; i < 2; ++i) { int R, C; stage_rc(tid * 16 + i * 8192, R, C); const int Rb = Epi::PERM ? ((R & ~31) + perm32(R & 31)) : R;
        voffA[i] = (unsigned)(R * lda + C) * 2u; voffB[i] = (unsigned)(Rb * K + C) * 2u; }
    const size_t kstep = (size_t)(BK * 2);
    const size_t hstepA = (size_t)HALF * lda * 2, hstepB = (size_t)HALF * K * 2;
    const size_t tstepA = 2 * hstepA, tstepB = 2 * hstepB;
    const unsigned ldsw = (unsigned)wid * 1024u;
    const int aoff = lds_byte(wr * 64 + fr, fq * 8), boff = lds_byte(wc * 32 + fr, fq * 8);
#define PG8_SA(b, h) (((b) * 2 + (h)) * HTB)
#define PG8_SB(b, h) ((4 + (b) * 2 + (h)) * HTB)
#define PG8_STAGE(bufoff, gbase, voff) do { _Pragma("unroll") for (int _i = 0; _i < 2; ++_i) \
        __builtin_amdgcn_global_load_lds((const unsigned*)((const char*)(gbase) + (voff)[_i]), (PG8_LAS unsigned*)(lds + (bufoff) + ldsw + _i * 8192), 16, 0, 0); } while (0)
#define PG8_LDA(dst, b, h) do { _Pragma("unroll") for (int m = 0; m < 4; ++m) _Pragma("unroll") for (int k = 0; k < 2; ++k) dst[m][k] = *(const PG8_LAS half8*)(lds + PG8_SA(b, h) + aoff + m * 2048 + k * 1024); } while (0)
#define PG8_LDB(dst, b, h) do { _Pragma("unroll") for (int n = 0; n < 2; ++n) _Pragma("unroll") for (int k = 0; k < 2; ++k) dst[n][k] = *(const PG8_LAS half8*)(lds + PG8_SB(b, h) + boff + n * 2048 + k * 1024); } while (0)
#define PG8_MMA(ai, bj, At, Bt) do { __builtin_amdgcn_s_setprio(1); _Pragma("unroll") for (int m = 0; m < 4; ++m) _Pragma("unroll") for (int n = 0; n < 2; ++n) _Pragma("unroll") for (int k = 0; k < 2; ++k) \
        acc[ai][bj][m][n] = __builtin_amdgcn_mfma_f32_16x16x32_f16(Bt[n][k], At[m][k], acc[ai][bj][m][n], 0, 0, 0); __builtin_amdgcn_s_setprio(0); } while (0)
#define PG8_WAIT_V(n) asm volatile("s_waitcnt vmcnt(" #n ")" ::: "memory")
#define PG8_WAIT_L(n) asm volatile("s_waitcnt lgkmcnt(" #n ")" ::: "memory")
#define PG8_BAR __builtin_amdgcn_s_barrier()
#define PG8_SCHED __builtin_amdgcn_sched_barrier(0)
    Unit cur, nxt; int ui = 0;
    if (!S_.next(0, cur)) return;
    f32x4 acc[2][2][4][2];
#pragma unroll
    for (int a = 0; a < 2; ++a)
#pragma unroll
        for (int b = 0; b < 2; ++b)
#pragma unroll
            for (int m = 0; m < 4; ++m)
#pragma unroll
                for (int n = 0; n < 2; ++n) acc[a][b][m][n] = (f32x4){0.f, 0.f, 0.f, 0.f};
    half8 At[4][2], B0[2][2], B1[2][2];
    const char* cA = (const char*)g.A + (size_t)cur.pm * tstepA; const char* cB = (const char*)g.Bt + (size_t)cur.pn * tstepB;
    PG8_STAGE(PG8_SB(0, 0), cB, voffB); PG8_STAGE(PG8_SB(0, 1), cB + hstepB, voffB); PG8_STAGE(PG8_SA(0, 0), cA, voffA); PG8_STAGE(PG8_SA(0, 1), cA + hstepA, voffA);
    if (wr == 1) PG8_BAR;
    PG8_WAIT_V(2); PG8_BAR;
    PG8_STAGE(PG8_SB(1, 0), cB + kstep, voffB); PG8_STAGE(PG8_SA(1, 0), cA + kstep, voffA); PG8_STAGE(PG8_SB(1, 1), cB + hstepB + kstep, voffB);
    PG8_WAIT_V(6); PG8_BAR;
    for (;;) {
        const bool has_next = S_.next(ui + 1, nxt);
        const char* nA = has_next ? (const char*)g.A + (size_t)nxt.pm * tstepA : cA; const char* nB = has_next ? (const char*)g.Bt + (size_t)nxt.pn * tstepB : cB;
        for (int t = 0; t < nt; t += 2) {
            const bool last = (t == nt - 2);
            const char* a1 = cA + (size_t)(t + 1) * kstep;
            const char* a2 = last ? nA : cA + (size_t)(t + 2) * kstep; const char* b2 = last ? nB : cB + (size_t)(t + 2) * kstep;
            const char* a3 = a2 + kstep; const char* b3 = b2 + kstep;
            PG8_LDB(B0, 0, 0); PG8_LDB(B1, 0, 1); PG8_SCHED; PG8_LDA(At, 0, 0); PG8_STAGE(PG8_SA(1, 1), a1 + hstepA, voffA);
            PG8_WAIT_V(8); PG8_WAIT_L(0); PG8_BAR; PG8_MMA(0, 0, At, B0); PG8_MMA(0, 1, At, B1); PG8_BAR; PG8_SCHED;
            PG8_LDA(At, 0, 1); PG8_STAGE(PG8_SB(0, 0), b2, voffB); PG8_STAGE(PG8_SB(0, 1), b2 + hstepB, voffB); PG8_STAGE(PG8_SA(0, 0), a2, voffA);
            PG8_WAIT_V(8); PG8_WAIT_L(0); PG8_BAR; PG8_MMA(1, 0, At, B0); PG8_MMA(1, 1, At, B1); PG8_BAR; PG8_SCHED;
            PG8_LDB(B0, 1, 0); PG8_LDB(B1, 1, 1); PG8_SCHED; PG8_LDA(At, 1, 0); PG8_STAGE(PG8_SA(0, 1), a2 + hstepA, voffA);
            PG8_WAIT_V(8); PG8_WAIT_L(0); PG8_BAR; PG8_MMA(0, 0, At, B0); PG8_MMA(0, 1, At, B1); PG8_BAR; PG8_SCHED;
            PG8_LDA(At, 1, 1); PG8_STAGE(PG8_SB(1, 0), b3, voffB); PG8_STAGE(PG8_SB(1, 1), b3 + hstepB, voffB); PG8_STAGE(PG8_SA(1, 0), a3, voffA);
            PG8_WAIT_V(8); PG8_WAIT_L(0); PG8_BAR; PG8_MMA(1, 0, At, B0); PG8_MMA(1, 1, At, B1); PG8_BAR; PG8_SCHED;
        }
        if (wr == 0) PG8_BAR;
        E(acc, cur, wr, wc, fr, fq, lds);
        if (!has_next) break;
#pragma unroll
        for (int a = 0; a < 2; ++a)
#pragma unroll
            for (int b = 0; b < 2; ++b)
#pragma unroll
                for (int m = 0; m < 4; ++m)
#pragma unroll
                    for (int n = 0; n < 2; ++n) acc[a][b][m][n] = (f32x4){0.f, 0.f, 0.f, 0.f};
        cur = nxt; cA = nA; cB = nB; ++ui;
        if (wr == 1) PG8_BAR;
    }
    PG8_WAIT_V(0);
    PG8_BAR;
#undef PG8_SA
#undef PG8_SB
#undef PG8_STAGE
#undef PG8_LDA
#undef PG8_LDB
#undef PG8_MMA
#undef PG8_WAIT_V
#undef PG8_WAIT_L
#undef PG8_BAR
#undef PG8_SCHED
}
}

struct Args {
    const float* x; const float* c; const int* positions; const float* w_in; const float* w_out; const float* w_ada; const float* b_ada; const float* norm_w;
    const float* cmp_w_k; const float* cmp_w_v; const float* cmp_pe_k; const float* cmp_pe_v; const float* sinks; const float* w_gate; const float* w_up;
    const float* conv_w; const float* conv_b; const float* w_down;
    float* out; unsigned char* ws;
    float inv_freq[32];
};

#define LDS_WAIT() asm volatile("s_waitcnt lgkmcnt(0)" ::: "memory")
#define MFMA16(a, b, c) __builtin_amdgcn_mfma_f32_16x16x32_f16((a), (b), (c), 0, 0, 0)
__device__ __forceinline__ float shx(float v, int m) { return __shfl_xor(v, m); }
__device__ __forceinline__ float wave_sum(float v) {
#pragma unroll
    for (int o = 1; o < 64; o <<= 1) v += __shfl_xor(v, o);
    return v;
}
__device__ __forceinline__ int rope_perm(int o) { return 16 * (o >> 5) + 4 * ((o >> 3) & 3) + (o & 3) + 32 * ((o >> 2) & 1); }
__device__ __forceinline__ int win_src_col(int p) {
    const int s = p >> 6, o = p & 63; int base;
    if (s < 10) base = 64 * s; else if (s < 38) base = 652 + 64 * (s - 10); else if (s == 38) return o < 12 ? 640 + o : -1; else return -1;
    const bool rope = (s < 5) || s == 6 || s == 8 || (s >= 10 && s < 22) || (s >= 28 && s < 36);
    return base + (rope ? rope_perm(o) : o);
}

template <bool KPERM = false, class SrcF>
__device__ __forceinline__ void transpose_item(const float* W, int ldw, int K, half_t* WT, int nblk, float* scr, int item, int lane, SrcF src) {
    const int kb = item / nblk, nb = item % nblk, k0 = 64 * kb, n0 = 32 * nb;
    const int sc = src(n0 + (lane & 31));
#pragma unroll 8
    for (int i = 0; i < 32; ++i) { const int kk = 2 * i + (lane >> 5); scr[kk * 33 + (lane & 31)] = sc >= 0 ? W[(size_t)(k0 + (KPERM ? rope_perm(kk) : kk)) * ldw + sc] : 0.f; }
    LDS_WAIT();
    const int c = lane & 7;
#pragma unroll
    for (int j = 0; j < 4; ++j) { const int n = (lane >> 3) + 8 * j; const float* s = scr + (8 * c) * 33 + n;
        u32x4 o; o.x = pg8::pkh(s[0 * 33], s[1 * 33]); o.y = pg8::pkh(s[2 * 33], s[3 * 33]); o.z = pg8::pkh(s[4 * 33], s[5 * 33]); o.w = pg8::pkh(s[6 * 33], s[7 * 33]);
        *(u32x4*)(WT + (size_t)(n0 + n) * K + k0 + 8 * c) = o; }
    LDS_WAIT();
}

template <bool HAS_H, bool HAS_XN, int XL, int XS>
__device__ __forceinline__ void rowwise_phase(const float* xf, half_t* x16, float* xo, const half_t* hs, const float* nwA, const float* gvec, const float* nwB, const float* scv, const float* shv, half_t* xn, int gw, int NW, int lane) {
    for (int b = 0; b < NBATCH; ++b) {
        f32x4 wA[4], gg[4], wB[4], sc1[4], sh[4];
#pragma unroll
        for (int j = 0; j < 4; ++j) {
            if (HAS_H) { wA[j] = *((const f32x4*)nwA + lane + 64 * j); gg[j] = *((const f32x4*)(gvec + (size_t)b * 6144) + lane + 64 * j); }
            if (HAS_XN) { wB[j] = *((const f32x4*)nwB + lane + 64 * j); sc1[j] = *((const f32x4*)(scv + (size_t)b * 6144) + lane + 64 * j) + 1.0f; sh[j] = *((const f32x4*)(shv + (size_t)b * 6144) + lane + 64 * j); }
        }
        const int mend = (b + 1) * S;
        f32x4 xq[4]; half4 xh[4], hq[4];
        {
            const int m0 = b * S + gw;
            if (m0 < mend) {
                if (XL == 0) { const f32x4* xr = (const f32x4*)(xf + (size_t)m0 * D) + lane;
#pragma unroll
                    for (int j = 0; j < 4; ++j) xq[j] = xr[64 * j]; }
                else { const half4* xr = (const half4*)(x16 + (size_t)m0 * D) + lane;
#pragma unroll
                    for (int j = 0; j < 4; ++j) xh[j] = xr[64 * j]; }
                if (HAS_H) { const half4* hr = (const half4*)(hs + (size_t)m0 * D) + lane;
#pragma unroll
                    for (int j = 0; j < 4; ++j) hq[j] = hr[64 * j]; }
            }
        }
        for (int m = b * S + gw; m < mend; m += NW) {
            f32x4 xv[4]; half4 hcur[4];
#pragma unroll
            for (int j = 0; j < 4; ++j) { if (XL == 0) xv[j] = xq[j]; else xv[j] = (f32x4){(float)xh[j][0], (float)xh[j][1], (float)xh[j][2], (float)xh[j][3]}; if (HAS_H) hcur[j] = hq[j]; }
            const int mn = (m + NW < mend) ? m + NW : m;
            {
                if (XL == 0) { const f32x4* xr = (const f32x4*)(xf + (size_t)mn * D) + lane;
#pragma unroll
                    for (int j = 0; j < 4; ++j) xq[j] = xr[64 * j]; }
                else { const half4* xr = (const half4*)(x16 + (size_t)mn * D) + lane;
#pragma unroll
                    for (int j = 0; j < 4; ++j) xh[j] = xr[64 * j]; }
                if (HAS_H) { const half4* hr = (const half4*)(hs + (size_t)mn * D) + lane;
#pragma unroll
                    for (int j = 0; j < 4; ++j) hq[j] = hr[64 * j]; }
            }
            if (HAS_H) {
                f32x4 hv[4]; float ss = 0.f;
#pragma unroll
                for (int j = 0; j < 4; ++j) { const half4 h4 = hcur[j]; hv[j] = (f32x4){(float)h4[0], (float)h4[1], (float)h4[2], (float)h4[3]}; ss += (hv[j][0] * hv[j][0] + hv[j][1] * hv[j][1]) + (hv[j][2] * hv[j][2] + hv[j][3] * hv[j][3]); }
                const float r = 1.0f / sqrtf(wave_sum(ss) * (1.f / D) + RMS_EPS);
#pragma unroll
                for (int j = 0; j < 4; ++j) xv[j] = xv[j] + gg[j] * (hv[j] * r * wA[j]);
            }
            if (XS == 1) {
                u32x2* xs = (u32x2*)(x16 + (size_t)m * D) + lane;
#pragma unroll
                for (int j = 0; j < 4; ++j) { u32x2 pk; pk.x = pg8::pkh(xv[j][0], xv[j][1]); pk.y = pg8::pkh(xv[j][2], xv[j][3]); xs[64 * j] = pk; }
            } else if (XS == 2) {
                f32x4* xs = (f32x4*)(xo + (size_t)m * D) + lane;
#pragma unroll
                for (int j = 0; j < 4; ++j) xs[64 * j] = xv[j];
            }
            if (HAS_XN) {
                float ss = 0.f;
#pragma unroll
                for (int j = 0; j < 4; ++j) ss += (xv[j][0] * xv[j][0] + xv[j][1] * xv[j][1]) + (xv[j][2] * xv[j][2] + xv[j][3] * xv[j][3]);
                const float r = 1.0f / sqrtf(wave_sum(ss) * (1.f / D) + RMS_EPS);
                u32x2* xo2 = (u32x2*)(xn + (size_t)m * D) + lane;
#pragma unroll
                for (int j = 0; j < 4; ++j) { const f32x4 o = (xv[j] * r * wB[j]) * sc1[j] + sh[j]; u32x2 pk; pk.x = pg8::pkh(o[0], o[1]); pk.y = pg8::pkh(o[2], o[3]); xo2[64 * j] = pk; }
            }
        }
    }
}

template <bool PV, class MK>
__device__ __forceinline__ void attn_run(int kb0, int kb_last, const half8 q0, const half8 q1, const half_t* kf, const half_t* vf, MK valid, f32x4 (&o)[4], float& m, float& l, int g) {
    for (int kb = kb0; kb <= kb_last; kb += 32) {
        const half_t* kp = kf + (size_t)(kb >> 5) * 2048;
        const half8 a00 = *(const half8*)kp, a01 = *(const half8*)(kp + 512), a10 = *(const half8*)(kp + 1024), a11 = *(const half8*)(kp + 1536);
        half8 vfr[4];
        if (PV) { const half_t* vp = vf + (size_t)(kb >> 5) * 2048;
#pragma unroll
            for (int dt = 0; dt < 4; ++dt) vfr[dt] = *(const half8*)(vp + dt * 512); }
        const f32x4 z = {0.f, 0.f, 0.f, 0.f};
        f32x4 s0 = MFMA16(a00, q0, z); s0 = MFMA16(a01, q1, s0);
        f32x4 s1 = MFMA16(a10, q0, z); s1 = MFMA16(a11, q1, s1);
        bool v0[4], v1[4]; float mx = -1e30f;
#pragma unroll
        for (int r = 0; r < 4; ++r) { const int key = kb + 4 * g + r; v0[r] = valid(key); v1[r] = valid(key + 16); if (v0[r]) mx = fmaxf(mx, s0[r]); if (v1[r]) mx = fmaxf(mx, s1[r]); }
        mx = fmaxf(mx, shx(mx, 16)); mx = fmaxf(mx, shx(mx, 32));
        const float mn = fmaxf(m, mx); const float corr = __builtin_amdgcn_exp2f(m - mn); m = mn;
        float p0[4], p1[4], ps = 0.f;
#pragma unroll
        for (int r = 0; r < 4; ++r) { p0[r] = v0[r] ? __builtin_amdgcn_exp2f(s0[r] - mn) : 0.f; p1[r] = v1[r] ? __builtin_amdgcn_exp2f(s1[r] - mn) : 0.f; ps += p0[r] + p1[r]; }
        l = l * corr + ps;
        if (PV) {
            const half8 pf = {(half_t)p0[0], (half_t)p0[1], (half_t)p0[2], (half_t)p0[3], (half_t)p1[0], (half_t)p1[1], (half_t)p1[2], (half_t)p1[3]};
#pragma unroll
            for (int dt = 0; dt < 4; ++dt) { o[dt] = o[dt] * corr; o[dt] = MFMA16(vfr[dt], pf, o[dt]); }
        }
    }
}

constexpr float RESC_THR = 12.0f;
template <int MODE, bool PV, class MK, class KB>
__device__ __forceinline__ void attn_run2(int nit, KB kbof, int maxblk, const half8 q0, const half8 q1, const half_t* kf, const half_t* vf, MK valid, f32x4 (&o)[4], float& m, float& l, int g,
                                          float* impq = nullptr, bool impw = false, int lane = 0) {
    if (nit <= 0) return;
    half8 ka[8], va[8];
    int kbA = kbof(0);
    {
        const int bA = kbA >> 5, bB = (bA + 1 <= maxblk) ? bA + 1 : maxblk;
        const half_t* kpA = kf + (size_t)bA * 2048; const half_t* kpB = kf + (size_t)bB * 2048;
#pragma unroll
        for (int i = 0; i < 4; ++i) { ka[i] = *(const half8*)(kpA + i * 512); ka[4 + i] = *(const half8*)(kpB + i * 512); }
        if (PV) { const half_t* vpA = vf + (size_t)bA * 2048; const half_t* vpB = vf + (size_t)bB * 2048;
#pragma unroll
            for (int i = 0; i < 4; ++i) { va[i] = *(const half8*)(vpA + i * 512); va[4 + i] = *(const half8*)(vpB + i * 512); } }
    }
    float carry = 0.f;
    for (int it = 0; it < nit; ++it) {
        const int kbN = kbof((it + 1 < nit) ? it + 1 : it);
        const int nbA = kbN >> 5, nbB = (nbA + 1 <= maxblk) ? nbA + 1 : maxblk;
        const f32x4 z = {0.f, 0.f, 0.f, 0.f};
        f32x4 s[4];
#pragma unroll
        for (int t = 0; t < 4; ++t) { s[t] = MFMA16(ka[2 * t], q0, z); s[t] = MFMA16(ka[2 * t + 1], q1, s[t]); }
        {
            const half_t* kpA = kf + (size_t)nbA * 2048; const half_t* kpB = kf + (size_t)nbB * 2048;
#pragma unroll
            for (int i = 0; i < 4; ++i) { ka[i] = *(const half8*)(kpA + i * 512); ka[4 + i] = *(const half8*)(kpB + i * 512); }
        }
        float p[4][4];
        if (MODE == 0) {
            bool vld[4][4]; float mx = -1e30f;
#pragma unroll
            for (int t = 0; t < 4; ++t)
#pragma unroll
                for (int r = 0; r < 4; ++r) { vld[t][r] = valid(kbA + 16 * t + 4 * g + r); if (vld[t][r]) mx = fmaxf(mx, s[t][r]); }
            if (__ballot(mx > m + RESC_THR) != 0ull) {
                mx = fmaxf(mx, shx(mx, 16)); mx = fmaxf(mx, shx(mx, 32));
                const float mn = fmaxf(m, mx); const float corr = __builtin_amdgcn_exp2f(m - mn); m = mn;
                l = l * corr;
                if (PV) {
#pragma unroll
                    for (int dt = 0; dt < 4; ++dt) o[dt] = o[dt] * corr;
                }
            }
            float ps = 0.f;
#pragma unroll
            for (int t = 0; t < 4; ++t)
#pragma unroll
                for (int r = 0; r < 4; ++r) { p[t][r] = vld[t][r] ? __builtin_amdgcn_exp2f(s[t][r] - m) : 0.f; ps += p[t][r]; }
            l = l + ps;
        } else {
#pragma unroll
            for (int t = 0; t < 4; ++t)
#pragma unroll
                for (int r = 0; r < 4; ++r) p[t][r] = valid(kbA + 16 * t + 4 * g + r) ? __builtin_amdgcn_exp2f(s[t][r] - m) * l : 0.f;
        }
        if (PV) {
            const half8 pfA = {(half_t)p[0][0], (half_t)p[0][1], (half_t)p[0][2], (half_t)p[0][3], (half_t)p[1][0], (half_t)p[1][1], (half_t)p[1][2], (half_t)p[1][3]};
            const half8 pfB = {(half_t)p[2][0], (half_t)p[2][1], (half_t)p[2][2], (half_t)p[2][3], (half_t)p[3][0], (half_t)p[3][1], (half_t)p[3][2], (half_t)p[3][3]};
#pragma unroll
            for (int dt = 0; dt < 4; ++dt) { o[dt] = MFMA16(va[dt], pfA, o[dt]); o[dt] = MFMA16(va[4 + dt], pfB, o[dt]); }
            const half_t* vpA = vf + (size_t)nbA * 2048; const half_t* vpB = vf + (size_t)nbB * 2048;
#pragma unroll
            for (int i = 0; i < 4; ++i) { va[i] = *(const half8*)(vpA + i * 512); va[4 + i] = *(const half8*)(vpB + i * 512); }
        }
        if (MODE == 1) {
            float A[4], B[4], Bup[4], Btop[4];
#pragma unroll
            for (int t = 0; t < 4; ++t) { A[t] = (p[t][0] + p[t][1]) + (p[t][2] + p[t][3]); B[t] = p[t][3]; A[t] += shx(A[t], 1); A[t] += shx(A[t], 2); B[t] += shx(B[t], 1); B[t] += shx(B[t], 2);
                Bup[t] = __shfl(B[t], (lane - 16) & 63); Btop[t] = __shfl(B[t], (lane & 15) + 48); }
#pragma unroll
            for (int t = 0; t < 4; ++t) { const float prev = g > 0 ? Bup[t] : (t == 0 ? carry : Btop[t > 0 ? t - 1 : 0]); if (impw) impq[(kbA >> 2) + 4 * t + g] = A[t] + prev; }
            carry = Btop[3];
        }
        kbA = kbN;
    }
}

template <int NS, int MODE, class MK, class KB>
__device__ __forceinline__ void attn_runN(int nit, KB kbof, int maxblk, const half8 (&qf)[NS][2], const half_t* kf, const half_t* vf, MK valid, f32x4 (&o)[NS][4], float (&m)[NS], float (&l)[NS], int g,
                                          float* impb = nullptr, int imps = 0, bool impw = false, int lane = 0) {
    if (nit <= 0) return;
    constexpr bool PV = MODE != 2;
    half8 ka[8], va[8];
    int kbA = kbof(0);
    {
        const int bA = kbA >> 5, bB = (bA + 1 <= maxblk) ? bA + 1 : maxblk;
        const half_t* kpA = kf + (size_t)bA * 2048; const half_t* kpB = kf + (size_t)bB * 2048;
#pragma unroll
        for (int i = 0; i < 4; ++i) { ka[i] = *(const half8*)(kpA + i * 512); ka[4 + i] = *(const half8*)(kpB + i * 512); }
        if (PV) { const half_t* vpA = vf + (size_t)bA * 2048; const half_t* vpB = vf + (size_t)bB * 2048;
#pragma unroll
            for (int i = 0; i < 4; ++i) { va[i] = *(const half8*)(vpA + i * 512); va[4 + i] = *(const half8*)(vpB + i * 512); } }
    }
    float carry[NS];
#pragma unroll
    for (int s_ = 0; s_ < NS; ++s_) carry[s_] = 0.f;
    for (int it = 0; it < nit; ++it) {
        const int kbN = kbof((it + 1 < nit) ? it + 1 : it);
        const int nbA = kbN >> 5, nbB = (nbA + 1 <= maxblk) ? nbA + 1 : maxblk;
        const f32x4 z = {0.f, 0.f, 0.f, 0.f};
#pragma unroll
        for (int s_ = 0; s_ < NS; ++s_) {
            f32x4 s[4];
#pragma unroll
            for (int t = 0; t < 4; ++t) { s[t] = MFMA16(ka[2 * t], qf[s_][0], z); s[t] = MFMA16(ka[2 * t + 1], qf[s_][1], s[t]); }
            if (s_ == NS - 1) {
                const half_t* kpA = kf + (size_t)nbA * 2048; const half_t* kpB = kf + (size_t)nbB * 2048;
#pragma unroll
                for (int i = 0; i < 4; ++i) { ka[i] = *(const half8*)(kpA + i * 512); ka[4 + i] = *(const half8*)(kpB + i * 512); }
            }
            if (MODE != 1) {
                float mx = -1e30f;
#pragma unroll
                for (int t = 0; t < 4; ++t)
#pragma unroll
                    for (int r = 0; r < 4; ++r) { if (valid(s_, kbA + 16 * t + 4 * g + r)) mx = fmaxf(mx, s[t][r]); }
                if (__ballot(mx > m[s_] + RESC_THR) != 0ull) {
                    mx = fmaxf(mx, shx(mx, 16)); mx = fmaxf(mx, shx(mx, 32));
                    const float mn = fmaxf(m[s_], mx); const float corr = __builtin_amdgcn_exp2f(m[s_] - mn); m[s_] = mn; l[s_] = l[s_] * corr;
                    if (PV) {
#pragma unroll
                        for (int dt = 0; dt < 4; ++dt) o[s_][dt] = o[s_][dt] * corr;
                    }
                }
            }
            float p[4][4]; float ps = 0.f;
#pragma unroll
            for (int t = 0; t < 4; ++t)
#pragma unroll
                for (int r = 0; r < 4; ++r) { p[t][r] = valid(s_, kbA + 16 * t + 4 * g + r) ? __builtin_amdgcn_exp2f(s[t][r] - m[s_]) : 0.f; if (MODE == 1) p[t][r] *= l[s_]; ps += p[t][r]; }
            if (MODE != 1) l[s_] = l[s_] + ps;
            if (PV) {
                const half8 pfA = {(half_t)p[0][0], (half_t)p[0][1], (half_t)p[0][2], (half_t)p[0][3], (half_t)p[1][0], (half_t)p[1][1], (half_t)p[1][2], (half_t)p[1][3]};
                const half8 pfB = {(half_t)p[2][0], (half_t)p[2][1], (half_t)p[2][2], (half_t)p[2][3], (half_t)p[3][0], (half_t)p[3][1], (half_t)p[3][2], (half_t)p[3][3]};
#pragma unroll
                for (int dt = 0; dt < 4; ++dt) { o[s_][dt] = MFMA16(va[dt], pfA, o[s_][dt]); o[s_][dt] = MFMA16(va[4 + dt], pfB, o[s_][dt]); }
            }
            if (MODE == 1) {
                float A[4], B[4], Bup[4], Btop[4];
#pragma unroll
                for (int t = 0; t < 4; ++t) { A[t] = (p[t][0] + p[t][1]) + (p[t][2] + p[t][3]); B[t] = p[t][3]; A[t] += shx(A[t], 1); A[t] += shx(A[t], 2); B[t] += shx(B[t], 1); B[t] += shx(B[t], 2);
                    Bup[t] = __shfl(B[t], (lane - 16) & 63); Btop[t] = __shfl(B[t], (lane & 15) + 48); }
#pragma unroll
                for (int t = 0; t < 4; ++t) { const float prev = g > 0 ? Bup[t] : (t == 0 ? carry[s_] : Btop[t > 0 ? t - 1 : 0]); if (impw) impb[s_ * imps + (kbA >> 2) + 4 * t + g] = A[t] + prev; }
                carry[s_] = Btop[3];
            }
        }
        if (PV) {
            const half_t* vpA = vf + (size_t)nbA * 2048; const half_t* vpB = vf + (size_t)nbB * 2048;
#pragma unroll
            for (int i = 0; i < 4; ++i) { va[i] = *(const half8*)(vpA + i * 512); va[4 + i] = *(const half8*)(vpB + i * 512); }
        }
        kbA = kbN;
    }
}

__device__ __forceinline__ half8 fp8x8_to_half8(u32x2 x) {
    const half2v a = __builtin_amdgcn_cvt_scalef32_pk_f16_fp8((int)x.x, 1.0f, false), b = __builtin_amdgcn_cvt_scalef32_pk_f16_fp8((int)x.x, 1.0f, true);
    const half2v c = __builtin_amdgcn_cvt_scalef32_pk_f16_fp8((int)x.y, 1.0f, false), d = __builtin_amdgcn_cvt_scalef32_pk_f16_fp8((int)x.y, 1.0f, true);
    return (half8){a.x, a.y, b.x, b.y, c.x, c.y, d.x, d.y};
}
template <class KB>
__device__ __forceinline__ void sel_run(int nit, KB kbof, const half8 (&qf)[2][2], const unsigned char* kf, const unsigned char* vf, const int (&tqs)[2], int qq,
                                        f32x4 (&o)[2][4], float (&m)[2], float (&l)[2], int g) {
    if (nit <= 0) return;
    u32x2 ka[8], va[8];
    int eA = kbof(0);
    int kbA = 64 * (eA & 255);
    {
        const unsigned char* kp = kf + (size_t)(kbA >> 5) * 2048; const unsigned char* vp = vf + (size_t)(kbA >> 5) * 2048;
#pragma unroll
        for (int i = 0; i < 8; ++i) { ka[i] = *(const u32x2*)(kp + i * 512); va[i] = *(const u32x2*)(vp + i * 512); }
    }
    for (int it = 0; it < nit; ++it) {
        const int eN = kbof((it + 1 < nit) ? it + 1 : it);
        const int kbN = 64 * (eN & 255);
        const unsigned maskA = (unsigned)eA >> 8;
        bool selq[2], need[2];
#pragma unroll
        for (int s_ = 0; s_ < 2; ++s_) { selq[s_] = ((maskA >> (4 * s_ + qq)) & 1u) != 0u; need[s_] = ((maskA >> (4 * s_)) & 15u) != 0u; }
        half8 kh[8];
#pragma unroll
        for (int i = 0; i < 8; ++i) kh[i] = fp8x8_to_half8(ka[i]);
        {
            const unsigned char* kp = kf + (size_t)(kbN >> 5) * 2048;
#pragma unroll
            for (int i = 0; i < 8; ++i) ka[i] = *(const u32x2*)(kp + i * 512);
        }
        const f32x4 z = {0.f, 0.f, 0.f, 0.f};
        f32x4 s[2][4];
#pragma unroll
        for (int s_ = 0; s_ < 2; ++s_)
            if (need[s_]) {
#pragma unroll
                for (int t = 0; t < 4; ++t) { s[s_][t] = MFMA16(kh[2 * t], qf[s_][0], z); s[s_][t] = MFMA16(kh[2 * t + 1], qf[s_][1], s[s_][t]); }
            }
        half8 vh[8];
#pragma unroll
        for (int i = 0; i < 8; ++i) vh[i] = fp8x8_to_half8(va[i]);
        {
            const unsigned char* vp = vf + (size_t)(kbN >> 5) * 2048;
#pragma unroll
            for (int i = 0; i < 8; ++i) va[i] = *(const u32x2*)(vp + i * 512);
        }
#pragma unroll
        for (int s_ = 0; s_ < 2; ++s_)
            if (need[s_]) {
                float p[4][4]; float mx = -1e30f;
                const int klim = selq[s_] ? tqs[s_] - kbA - 4 * g : -1;
#pragma unroll
                for (int t = 0; t < 4; ++t)
#pragma unroll
                    for (int r = 0; r < 4; ++r) { if (16 * t + r <= klim) mx = fmaxf(mx, s[s_][t][r]); }
                if (__ballot(mx > m[s_] + RESC_THR) != 0ull) {
                    mx = fmaxf(mx, shx(mx, 16)); mx = fmaxf(mx, shx(mx, 32));
                    const float mn = fmaxf(m[s_], mx); const float corr = __builtin_amdgcn_exp2f(m[s_] - mn); m[s_] = mn;
                    l[s_] = l[s_] * corr;
#pragma unroll
                    for (int dt = 0; dt < 4; ++dt) o[s_][dt] = o[s_][dt] * corr;
                }
                float ps = 0.f;
#pragma unroll
                for (int t = 0; t < 4; ++t)
#pragma unroll
                    for (int r = 0; r < 4; ++r) { p[t][r] = (16 * t + r <= klim) ? __builtin_amdgcn_exp2f(s[s_][t][r] - m[s_]) : 0.f; ps += p[t][r]; }
                l[s_] = l[s_] + ps;
                const half8 pfA = {(half_t)p[0][0], (half_t)p[0][1], (half_t)p[0][2], (half_t)p[0][3], (half_t)p[1][0], (half_t)p[1][1], (half_t)p[1][2], (half_t)p[1][3]};
                const half8 pfB = {(half_t)p[2][0], (half_t)p[2][1], (half_t)p[2][2], (half_t)p[2][3], (half_t)p[3][0], (half_t)p[3][1], (half_t)p[3][2], (half_t)p[3][3]};
#pragma unroll
                for (int dt = 0; dt < 4; ++dt) { o[s_][dt] = MFMA16(vh[dt], pfA, o[s_][dt]); o[s_][dt] = MFMA16(vh[4 + dt], pfB, o[s_][dt]); }
            }
        kbA = kbN; eA = eN;
    }
}

struct ACtx { const half_t* proj; const half_t* kc; const half_t* vct; const half_t* vt; const half_t* kf; half_t* mix; float* lse; const float* sinks; const unsigned char* ks8; const unsigned char* vs8; };

__device__ __forceinline__ void a_unit(const ACtx& X, int b, int t0, float* ldsw, int lane) {
    const int c = lane & 15, g = lane >> 4, loff = (c * 4 + g) * 8;
    float* outT = ldsw;
    float* impL = ldsw + 2048;
    unsigned* qbits = (unsigned*)(ldsw + 4096);
    int* ulist = (int*)(ldsw + 4160);
    const size_t rowb = (size_t)b * S;
    const half_t* P = X.proj;
    qbits[lane] = 0u;
    for (int i = lane; i < 2048; i += 64) impL[i] = 0.f;
    {
        const int qq = c >> 2, h = c & 3;
        half8 qf[2][2]; int tqs[2], nval[2];
#pragma unroll
        for (int s_ = 0; s_ < 2; ++s_) { tqs[s_] = t0 + 4 * s_ + qq; nval[s_] = (tqs[s_] >= 31) ? ((tqs[s_] - 31) >> 4) : -1;
            const half_t* qrow = P + (rowb + tqs[s_]) * NPROJ + h * 64; qf[s_][0] = *(const half8*)(qrow + 8 * g); qf[s_][1] = *(const half8*)(qrow + 32 + 8 * g); }
        const int tqmax = t0 + 7;
        const int nlast = (tqmax >= 31) ? ((tqmax - 31) >> 4) : -1;
        const half_t* kcb = X.kc + (size_t)b * 1024 * 64 + loff;
        const half_t* vcb = X.vct + (size_t)b * 64 * 1024 + loff;
        auto valid = [&](int s_, int n) { return n <= nval[s_]; };
        float m[2] = {-1e30f, -1e30f}, l[2] = {0.f, 0.f}; f32x4 o[2][4];
#pragma unroll
        for (int s_ = 0; s_ < 2; ++s_)
#pragma unroll
            for (int dt = 0; dt < 4; ++dt) o[s_][dt] = (f32x4){0.f, 0.f, 0.f, 0.f};
        const int nitc = (nlast >= 0) ? ((nlast >> 6) + 1) : 0;
        auto kbc = [&](int it) { return 64 * it; };
        attn_runN<2, 2>(nitc, kbc, 31, qf, kcb, vcb, valid, o, m, l, g);
#pragma unroll
        for (int s_ = 0; s_ < 2; ++s_) { float ls = l[s_]; ls += shx(ls, 16); ls += shx(ls, 32); l[s_] = ls > 0.f ? 1.f / ls : 0.f; }
        attn_runN<2, 1>(nitc, kbc, 31, qf, kcb, vcb, valid, o, m, l, g, impL + qq * 256, 1024, h == 0, lane);
#pragma unroll
        for (int s_ = 0; s_ < 2; ++s_) {
            const float gc = (float)P[(rowb + tqs[s_]) * NPROJ + 38 * 64 + h * 3 + 0];
#pragma unroll
            for (int dt = 0; dt < 4; ++dt)
#pragma unroll
                for (int r = 0; r < 4; ++r) outT[((4 * s_ + qq) * 4 + h) * 64 + 16 * dt + 4 * g + r] = gc * o[s_][dt][r];
        }
    }
    LDS_WAIT(); __builtin_amdgcn_wave_barrier();
    for (int qi = 0; qi < 8; ++qi) {
        const int tqq = t0 + qi, cur = tqq >> 6, cnt = (cur + 1 < 16) ? cur + 1 : 16;
        unsigned key[4];
#pragma unroll
        for (int i = 0; i < 4; ++i) { const int j = lane + 64 * i; const float v = (j == 0 || j == cur || j == cur - 1) ? 1e4f : fmaxf(impL[qi * 256 + j], 0.f); key[i] = (j > cur) ? 0u : (__float_as_uint(v) + 1u); }
        unsigned T = 0u;
        for (int bit = 30; bit >= 0; --bit) {
            const unsigned cand = T | (1u << bit);
            int cge = 0;
#pragma unroll
            for (int i = 0; i < 4; ++i) cge += __popcll(__ballot(key[i] >= cand));
            if (cge >= cnt) T = cand;
        }
        int ngt = 0;
#pragma unroll
        for (int i = 0; i < 4; ++i) ngt += __popcll(__ballot(key[i] > T));
        int need = cnt - ngt, base = 0;
#pragma unroll
        for (int i = 0; i < 4; ++i) {
            const unsigned long long Me = __ballot(key[i] == T);
            const int pos = base + (int)__builtin_amdgcn_mbcnt_hi((unsigned)(Me >> 32), __builtin_amdgcn_mbcnt_lo((unsigned)Me, 0u));
            const bool sel = (key[i] > T) || (key[i] == T && pos < need);
            const unsigned long long Ms = __ballot(sel);
            if (lane == 0) { qbits[qi * 8 + 2 * i] = (unsigned)Ms; qbits[qi * 8 + 2 * i + 1] = (unsigned)(Ms >> 32); }
            base += __popcll(Me);
        }
    }
    LDS_WAIT(); __builtin_amdgcn_wave_barrier();
    {
        int nun = 0;
#pragma unroll
        for (int i = 0; i < 4; ++i) {
            const int j = lane + 64 * i, w = j >> 5; unsigned u = 0u;
#pragma unroll
            for (int q = 0; q < 8; ++q) u |= ((qbits[q * 8 + w] >> (j & 31)) & 1u) << q;
            const bool pr = u != 0u;
            const unsigned long long Mb = __ballot(pr);
            const int pos = nun + (int)__builtin_amdgcn_mbcnt_hi((unsigned)(Mb >> 32), __builtin_amdgcn_mbcnt_lo((unsigned)Mb, 0u));
            if (pr) ulist[pos] = j | (int)(u << 8);
            nun += __popcll(Mb);
        }
        LDS_WAIT(); __builtin_amdgcn_wave_barrier();
        const int qq = c >> 2, h = c & 3;
        half8 qf[2][2]; int tqs[2];
#pragma unroll
        for (int s_ = 0; s_ < 2; ++s_) { tqs[s_] = t0 + 4 * s_ + qq; const half_t* qrow = P + (rowb + tqs[s_]) * NPROJ + h * 64; qf[s_][0] = *(const half8*)(qrow + 8 * g); qf[s_][1] = *(const half8*)(qrow + 32 + 8 * g); }
        const unsigned char* kb_ = X.ks8 + (size_t)b * 64 * S + loff;
        const unsigned char* vb_ = X.vs8 + (size_t)b * 64 * S + loff;
        f32x4 o[2][4]; float m[2] = {-1e30f, -1e30f}, l[2] = {0.f, 0.f};
#pragma unroll
        for (int s_ = 0; s_ < 2; ++s_)
#pragma unroll
            for (int dt = 0; dt < 4; ++dt) o[s_][dt] = (f32x4){0.f, 0.f, 0.f, 0.f};
        auto kbs = [&](int it) { return __builtin_amdgcn_readfirstlane(ulist[it]); };
        sel_run(nun, kbs, qf, kb_, vb_, tqs, qq, o, m, l, g);
#pragma unroll
        for (int s_ = 0; s_ < 2; ++s_) {
            float ls = l[s_]; ls += shx(ls, 16); ls += shx(ls, 32);
            const float gs = (float)P[(rowb + tqs[s_]) * NPROJ + 38 * 64 + h * 3 + 1] / fmaxf(ls, 1e-30f);
#pragma unroll
            for (int dt = 0; dt < 4; ++dt)
#pragma unroll
                for (int r = 0; r < 4; ++r) outT[((4 * s_ + qq) * 4 + h) * 64 + 16 * dt + 4 * g + r] += gs * o[s_][dt][r];
        }
        LDS_WAIT(); __builtin_amdgcn_wave_barrier();
    }
    {
        const int q8 = c & 7, tq = t0 + q8;
        half8 qf[2][2];
#pragma unroll
        for (int s_ = 0; s_ < 2; ++s_) { const half_t* qrow = P + (rowb + tq) * NPROJ + (2 * s_ + (c >> 3)) * 64; qf[s_][0] = *(const half8*)(qrow + 8 * g); qf[s_][1] = *(const half8*)(qrow + 32 + 8 * g); }
        const half_t* kb_ = X.kf + (size_t)(1 * 2 + b) * 64 * S + loff;
        const half_t* vb_ = X.vt + (size_t)(1 * 2 + b) * 64 * S + loff;
        auto valid = [&](int, int key) { return key <= tq && tq - key <= 511; };
        float m[2] = {-1e30f, -1e30f}, l[2] = {0.f, 0.f}; f32x4 o[2][4];
#pragma unroll
        for (int s_ = 0; s_ < 2; ++s_)
#pragma unroll
            for (int dt = 0; dt < 4; ++dt) o[s_][dt] = (f32x4){0.f, 0.f, 0.f, 0.f};
        const int lo_ = t0 - 511; const int kb0 = (lo_ > 0 ? lo_ : 0) & ~31;
        auto kbw = [&](int it) { return kb0 + 64 * it; };
        attn_runN<2, 0>(((((t0 + 7) >> 5) - (kb0 >> 5)) >> 1) + 1, kbw, S / 32 - 1, qf, kb_, vb_, valid, o, m, l, g);
#pragma unroll
        for (int s_ = 0; s_ < 2; ++s_) {
            const int h = 2 * s_ + (c >> 3);
            float ls = l[s_]; ls += shx(ls, 16); ls += shx(ls, 32);
            const float gwv = (float)P[(rowb + tq) * NPROJ + 38 * 64 + h * 3 + 2] / ls;
#pragma unroll
            for (int dt = 0; dt < 4; ++dt)
#pragma unroll
                for (int r = 0; r < 4; ++r) outT[(q8 * 4 + h) * 64 + 16 * dt + 4 * g + r] += gwv * o[s_][dt][r];
        }
        LDS_WAIT(); __builtin_amdgcn_wave_barrier();
    }
#pragma unroll
    for (int q = 0; q < 8; ++q) {
        const f32x4 v = *(const f32x4*)(outT + q * 256 + 4 * lane);
        u32x2 pk; pk.x = pg8::pkh(v[0], v[1]); pk.y = pg8::pkh(v[2], v[3]);
        *(u32x2*)(X.mix + (rowb + t0 + q) * D + 4 * lane) = pk;
    }
    LDS_WAIT(); __builtin_amdgcn_wave_barrier();
}

__device__ __forceinline__ void b_unit(const ACtx& X, int b, int h6, int fb, int lane) {
    const int c = lane & 15, g = lane >> 4;
    const int sh = 2 * (h6 >> 1), dil = 1 << sh, n = S >> sh, bpc = n >> 5;
    const int r = fb / bpc, i0 = (fb % bpc) * 32;
    const size_t rowb = (size_t)b * S;
    const half_t* P = X.proj;
    half8 qf[2][2]; int iqs[2], tls[2];
#pragma unroll
    for (int s_ = 0; s_ < 2; ++s_) { iqs[s_] = i0 + 16 * s_ + c; tls[s_] = iqs[s_] * dil + r; const half_t* qrow = P + (rowb + tls[s_]) * NPROJ + (10 + h6) * 64; qf[s_][0] = *(const half8*)(qrow + 8 * g); qf[s_][1] = *(const half8*)(qrow + 32 + 8 * g); }
    const int loff = (c * 4 + g) * 8;
    const half_t* kb_ = X.kf + (size_t)((2 + h6) * 2 + b) * 64 * S + (size_t)r * n * 64 + loff;
    const half_t* vb_ = X.vt + (size_t)((2 + h6) * 2 + b) * 64 * S + (size_t)r * n * 64 + loff;
    auto valid = [&](int s_, int kf) { return kf <= iqs[s_] && iqs[s_] - kf <= 128; };
    float m[2] = {-1e30f, -1e30f}, l[2] = {0.f, 0.f}; f32x4 o[2][4];
#pragma unroll
    for (int s_ = 0; s_ < 2; ++s_)
#pragma unroll
        for (int dt = 0; dt < 4; ++dt) o[s_][dt] = (f32x4){0.f, 0.f, 0.f, 0.f};
    const int lo_ = i0 - 128; const int kb0 = (lo_ > 0 ? lo_ : 0) & ~31;
    auto kbw = [&](int it) { return kb0 + 64 * it; };
    attn_runN<2, 0>(((((i0 + 31) >> 5) - (kb0 >> 5)) >> 1) + 1, kbw, (n >> 5) - 1, qf, kb_, vb_, valid, o, m, l, g);
#pragma unroll
    for (int s_ = 0; s_ < 2; ++s_) {
        float ls = l[s_]; ls += shx(ls, 16); ls += shx(ls, 32);
        const float inv = 1.f / ls;
        half_t* op = X.mix + (rowb + tls[s_]) * D + (4 + h6) * 64 + 4 * g;
#pragma unroll
        for (int dt = 0; dt < 4; ++dt) { u32x2 pk; pk.x = pg8::pkh(o[s_][dt][0] * inv, o[s_][dt][1] * inv); pk.y = pg8::pkh(o[s_][dt][2] * inv, o[s_][dt][3] * inv); *(u32x2*)(op + 16 * dt) = pk; }
        if (g == 0) X.lse[(rowb + tls[s_]) * 6 + h6] = m[s_] + __builtin_amdgcn_logf(ls);
    }
}

__device__ __forceinline__ void c_unit(const ACtx& X, int b, int kvh, int qb, int lane) {
    const int c = lane & 15, g = lane >> 4;
    const int t0 = qb * 16, tq = t0 + c;
    const size_t rowb = (size_t)b * S;
    const half_t* P = X.proj;
    half8 qf[3][2]; float m[3], l[3]; f32x4 o[3][4];
#pragma unroll
    for (int s_ = 0; s_ < 3; ++s_) { const half_t* qrow = P + (rowb + tq) * NPROJ + (28 + 3 * kvh + s_) * 64; qf[s_][0] = *(const half8*)(qrow + 8 * g); qf[s_][1] = *(const half8*)(qrow + 32 + 8 * g);
        m[s_] = X.sinks[3 * kvh + s_] * LOG2E; l[s_] = (g == 0) ? 1.f : 0.f;
#pragma unroll
        for (int dt = 0; dt < 4; ++dt) o[s_][dt] = (f32x4){0.f, 0.f, 0.f, 0.f}; }
    const int loff = (c * 4 + g) * 8;
    const half_t* kb_ = X.kf + (size_t)((8 + kvh) * 2 + b) * 64 * S + loff;
    const half_t* vb_ = X.vt + (size_t)((8 + kvh) * 2 + b) * 64 * S + loff;
    auto valid = [&](int, int key) { return key <= tq && tq - key <= 127; };
    const int lo_ = t0 - 127; const int kb0 = (lo_ > 0 ? lo_ : 0) & ~31;
    auto kbw = [&](int it) { return kb0 + 64 * it; };
    attn_runN<3, 0>(((((t0 + 15) >> 5) - (kb0 >> 5)) >> 1) + 1, kbw, S / 32 - 1, qf, kb_, vb_, valid, o, m, l, g);
#pragma unroll
    for (int s_ = 0; s_ < 3; ++s_) {
        float ls = l[s_]; ls += shx(ls, 16); ls += shx(ls, 32);
        const float inv = 1.f / ls;
        half_t* op = X.mix + (rowb + tq) * D + (10 + 3 * kvh + s_) * 64 + 4 * g;
#pragma unroll
        for (int dt = 0; dt < 4; ++dt) { u32x2 pk; pk.x = pg8::pkh(o[s_][dt][0] * inv, o[s_][dt][1] * inv); pk.y = pg8::pkh(o[s_][dt][2] * inv, o[s_][dt][3] * inv); *(u32x2*)(op + 16 * dt) = pk; }
    }
}

__device__ __forceinline__ float gelu_tanh(float v) {
    const float z = 0.7978845608028654f * (v + 0.044715f * v * v * v);
    const float t = __expf(2.f * z);
    const float th = 1.f - 2.f / (t + 1.f);
    return 0.5f * v * (1.f + th);
}

#ifndef PH
#define PH 0xFFFF
#endif
#ifndef REP
#define REP 0
#endif
typedef const Args __attribute__((address_space(4)))* ArgsP;
__device__ __forceinline__ ArgsP largs() { auto p = __builtin_amdgcn_kernarg_segment_ptr(); asm volatile("" : "+s"(p)); return (ArgsP)p; }
struct Ids { int tid, lane, wave, G, NW, gw, gtid, NT; };
__device__ __forceinline__ Ids make_ids() {
    Ids I; int t = threadIdx.x; asm volatile("" : "+v"(t));
    int bid = blockIdx.x; asm volatile("" : "+s"(bid));
    I.tid = t; I.lane = t & 63; I.wave = __builtin_amdgcn_readfirstlane(t >> 6); I.G = gridDim.x; I.NW = I.G * NWAVES; I.gw = bid * NWAVES + I.wave;
    I.gtid = bid * NTHREADS + t; I.NT = I.G * NTHREADS; return I;
}
__device__ __forceinline__ int opaque_bid() { int bid = blockIdx.x; asm volatile("" : "+s"(bid)); return bid; }
__device__ __forceinline__ unsigned char* ws_base(ArgsP a) {
    const unsigned long long v = (unsigned long long)a->ws;
    unsigned lo = __builtin_amdgcn_readfirstlane((unsigned)v), hi = __builtin_amdgcn_readfirstlane((unsigned)(v >> 32));
    asm volatile("" : "+s"(lo), "+s"(hi));
    return (unsigned char*)(((unsigned long long)hi << 32) | lo);
}

__device__ __forceinline__ void phase_p0a(ArgsP a, unsigned char* lds) {
    const Ids I = make_ids(); unsigned char* ws = ws_base(a);
    const int tid = I.tid, lane = I.lane, wave = I.wave, G = I.G;
    half_t* wt_in = (half_t*)(ws + WS_WT_IN); half_t* wt_out = (half_t*)(ws + WS_WT_OUT); half_t* wt_dn = (half_t*)(ws + WS_WT_DN);
    float* cosT = (float*)(ws + WS_COS); float* sinT = (float*)(ws + WS_SIN); float* ada = (float*)(ws + WS_ADA);
    float* red = (float*)(lds + 80 * 1024);
    for (int item = opaque_bid(); item < DEPTH * 96; item += G) {
        const int l = item / 96, jc = item % 96, jl = tid & 63, j = jc * 64 + jl, kg = tid >> 6;
        float a0 = 0.f, a1 = 0.f;
        for (int k0 = kg * 128; k0 < kg * 128 + 128; k0 += 16) {
            float w[16];
#pragma unroll
            for (int u = 0; u < 16; ++u) w[u] = a->w_ada[((size_t)l * D + k0 + u) * 6144 + j];
#pragma unroll
            for (int u = 0; u < 16; ++u) { const float c0 = a->c[k0 + u], c1 = a->c[D + k0 + u]; a0 += (c0 / (1.f + __expf(-c0))) * w[u]; a1 += (c1 / (1.f + __expf(-c1))) * w[u]; }
        }
        red[(kg * 64 + jl) * 2 + 0] = a0; red[(kg * 64 + jl) * 2 + 1] = a1;
        __syncthreads();
        if (tid < 128) { const int jj = tid & 63, bb = tid >> 6; float s = 0.f;
#pragma unroll
            for (int q = 0; q < 8; ++q) s += red[(q * 64 + jj) * 2 + bb];
            ada[((size_t)l * 2 + bb) * 6144 + jc * 64 + jj] = s + a->b_ada[(size_t)l * 6144 + jc * 64 + jj]; }
        __syncthreads();
    }
    float* scr = (float*)lds + wave * (64 * 33);
    constexpr int I_IN = 16 * (NPROJ / 32), I_OUT = 16 * (D / 32), I_DN = (DFF / 64) * (D / 32);
    constexpr int NITEMS = DEPTH * (I_IN + I_OUT + I_DN);
    for (int it = I.gw; it < NITEMS; it += I.NW) {
        int r = it;
        if (r < DEPTH * I_IN) { const int l = r / I_IN; r %= I_IN; transpose_item(a->w_in + (size_t)l * D * NIN, NIN, D, wt_in + (size_t)l * NPROJ * D, NPROJ / 32, scr, r, lane, [](int p) { return win_src_col(p); }); continue; }
        r -= DEPTH * I_IN;
        if (r < DEPTH * I_OUT) { const int l = r / I_OUT; r %= I_OUT; transpose_item(a->w_out + (size_t)l * D * D, D, D, wt_out + (size_t)l * D * D, D / 32, scr, r, lane, [](int p) { return p; }); continue; }
        r -= DEPTH * I_OUT;
        { const int l = r / I_DN; r %= I_DN; transpose_item(a->w_down + (size_t)l * DFF * D, D, DFF, wt_dn + (size_t)l * D * DFF, D / 32, scr, r, lane, [](int p) { return p; }); }
    }
    {
        half_t* cw = (half_t*)(ws + WS_CW); float* cbias = (float*)(ws + WS_CB);
        for (int it = I.gw; it < DEPTH * 2 * 64; it += I.NW) {
            const int l = it >> 7, kv = (it >> 6) & 1, r = it & 63;
            if (kv == 0) transpose_item<true>(a->cmp_w_k + (size_t)l * 2048 * 64, 64, 2048, cw + (size_t)(l * 2 + 0) * 64 * 2048, 2, scr, r, lane, [](int p) { return rope_perm(p); });
            else transpose_item<false>(a->cmp_w_v + (size_t)l * 2048 * 64, 64, 2048, cw + (size_t)(l * 2 + 1) * 64 * 2048, 2, scr, r, lane, [](int p) { return p; });
        }
        for (int it = I.gw; it < DEPTH * 2; it += I.NW) {
            const int l = it >> 1, kv = it & 1;
            const float* w = (kv == 0 ? a->cmp_w_k : a->cmp_w_v) + (size_t)l * 2048 * 64; const float* pe = (kv == 0 ? a->cmp_pe_k : a->cmp_pe_v) + (size_t)l * 2048;
            const int e = kv == 0 ? rope_perm(lane) : lane; float acc = 0.f;
            for (int k = 0; k < 2048; ++k) acc += pe[k] * w[(size_t)k * 64 + e];
            cbias[(l * 2 + kv) * 64 + lane] = acc;
        }
    }
    for (int idx = I.gtid; idx < M * 32; idx += I.NT) {
        const int mrow = idx >> 5, i = idx & 31;
        const float ang = (float)a->positions[mrow] * a->inv_freq[i];
        const double xd = (double)ang; const double kq = rint(xd * 0.15915494309189535);
        const float rf = (float)fma(-kq, 6.283185307179586, xd);
        cosT[idx] = cosf(rf); sinT[idx] = sinf(rf);
    }
}

__device__ __forceinline__ void phase_p0b(ArgsP a) {
    const Ids I = make_ids(); unsigned char* ws = ws_base(a);
    const float* ada = (const float*)(ws + WS_ADA); half_t* hx = (half_t*)(ws + WS_HX);
    rowwise_phase<false, true, 0, 0>(a->x, nullptr, nullptr, nullptr, nullptr, nullptr, a->norm_w + 0 * D, ada + 1024, ada + 0, hx, I.gw, I.NW, I.lane);
}

__device__ __forceinline__ void phase_inproj(ArgsP a, int layer, unsigned char* lds) {
    unsigned char* ws = ws_base(a);
    pg8::Gemm g{(const half_t*)(ws + WS_HX), (const half_t*)(ws + WS_WT_IN) + (size_t)layer * NPROJ * D, M, NPROJ, D, D};
    pg8::StaticOrder So; So.init(M, NPROJ, (int)gridDim.x, opaque_bid());
    pg8::EpiProj E{(half_t*)(ws + WS_PROJ), (const float*)(ws + WS_COS), (const float*)(ws + WS_SIN), (half_t*)(ws + WS_VT), (half_t*)(ws + WS_KF), ws + WS_KS8, ws + WS_VS8};
    pg8::gemm_phase<pg8::EpiProj>((PG8_LAS unsigned char*)lds, g, So, E);
}

__device__ __forceinline__ void phase_compress(ArgsP a, int layer, unsigned char* lds) {
    const Ids I = make_ids(); unsigned char* ws = ws_base(a);
    const int lane = I.lane;
    const half_t* proj = (const half_t*)(ws + WS_PROJ); half_t* kc = (half_t*)(ws + WS_KC); half_t* vct = (half_t*)(ws + WS_VCT); half_t* wt_gu = (half_t*)(ws + WS_WT_GU);
    {
        const half_t* cw = (const half_t*)(ws + WS_CW) + (size_t)layer * 2 * 64 * 2048; const float* cbias = (const float*)(ws + WS_CB) + layer * 128;
        const int c = lane & 15, g = lane >> 4;
        for (int wu = I.gw - (I.NW - 1024); wu >= 0 && wu < 1024; wu += I.NW) {
            const int kv = wu >> 9, b = (wu >> 8) & 1, nb = (wu >> 2) & 63, et = wu & 3;
            const int nrow = 16 * nb + c;
            const half_t* wrow = cw + ((size_t)kv * 64 + 16 * et + c) * 2048 + 8 * g;
            const half_t* xcol = proj + (size_t)b * S * NPROJ + (4 + kv) * 64 + 8 * g;
            f32x4 acc = {0.f, 0.f, 0.f, 0.f};
#pragma unroll 1
            for (int k8 = 0; k8 < 64; k8 += 8) {
                half8 af[8], bf[8];
#pragma unroll
                for (int u = 0; u < 8; ++u) { const int ks = k8 + u; int tok = 16 * nrow + (ks >> 1); tok = tok < S ? tok : S - 1;
                    af[u] = *(const half8*)(xcol + (size_t)tok * NPROJ + 32 * (ks & 1)); bf[u] = *(const half8*)(wrow + 32 * ks); }
#pragma unroll
                for (int u = 0; u < 8; ++u) acc = MFMA16(af[u], bf[u], acc);
            }
            const float bs = cbias[kv * 64 + 16 * et + c];
#pragma unroll
            for (int r = 0; r < 4; ++r) {
                const int n = 16 * nb + 4 * g + r, e = 16 * et + c;
                const float v = (n == 1023) ? 0.f : acc[r] + bs;
                if (kv == 0) kc[(size_t)b * 65536 + (size_t)(n >> 5) * 2048 + ((((n >> 4) & 1) * 2 + (e >> 5)) * 64 + (n & 15) * 4 + ((e >> 3) & 3)) * 8 + (e & 7)] = (half_t)v;
                else vct[(size_t)b * 65536 + (size_t)(n >> 5) * 2048 + (e * 4 + ((n & 15) >> 2)) * 8 + (n & 3) + 4 * ((n >> 4) & 1)] = (half_t)v;
            }
        }
    }
    float* scr = (float*)lds + I.wave * (64 * 33);
    constexpr int I_G = 16 * (DFF / 32);
    const float* wg = a->w_gate + (size_t)layer * D * DFF; const float* wu_ = a->w_up + (size_t)layer * D * DFF;
    for (int it = I.gw; it < 2 * I_G; it += I.NW) {
        const int up = it >= I_G, r = up ? it - I_G : it, n0 = 32 * (r % (DFF / 32));
        const long dsh = (long)(256 * (n0 >> 7) + (n0 & 127) + 128 * up) - n0;
        transpose_item(up ? wu_ : wg, DFF, D, wt_gu + dsh * D, DFF / 32, scr, r, lane, [](int p) { return p; });
    }
}

__device__ __forceinline__ void phase_attn(ArgsP a, int layer, unsigned char* lds) {
    const Ids I = make_ids(); unsigned char* ws = ws_base(a);
    ACtx X{(const half_t*)(ws + WS_PROJ), (const half_t*)(ws + WS_KC), (const half_t*)(ws + WS_VCT), (const half_t*)(ws + WS_VT), (const half_t*)(ws + WS_KF), (half_t*)(ws + WS_MIX), (float*)(ws + WS_LSE), a->sinks + layer * 6, ws + WS_KS8, ws + WS_VS8};
    float* ldsw = (float*)lds + I.wave * 4288;
    const int pb = I.gw >> 3;
    const int vb = ((I.G & 7) == 0) ? (pb & 7) * (I.G >> 3) + (pb >> 3) : pb;
    const int vgw = vb * 8 + (I.gw & 7);
    for (int i = 0; i < 2; ++i) {
        const int ua = (i == 0) ? vgw : (4095 - vgw);
        if (ua >= 0 && ua < 4096) a_unit(X, ua >> 11, (ua & 2047) * 8, ldsw, I.lane);
    }
    if (I.G == 256) {
        const int bid = vb;
        int start = 0;
        for (int b2 = 0; b2 < bid; ++b2) { const int e2 = 2 * b2 - 255; start += 8 * (3 + (((e2 < 0 ? -e2 : e2) + 32) >> 6)); }
        const int e1 = 2 * bid - 255; const int n = 3 + (((e1 < 0 ? -e1 : e1) + 32) >> 6);
        start += (I.gw & 7) * n;
        for (int k = start; k < start + n; ++k) {
            if (k < 6144) { const int b = k / 3072, rem = k % 3072; b_unit(X, b, rem >> 9, rem & 511, I.lane); }
            else { const int u = k - 6144; const int b = u >> 11, rem = u & 2047; c_unit(X, b, rem >> 10, rem & 1023, I.lane); }
        }
    } else {
        for (int u = vgw; u < 6144; u += I.NW) { const int b = u / 3072, rem = u % 3072; b_unit(X, b, rem >> 9, rem & 511, I.lane); }
        for (int u = vgw; u < 4096; u += I.NW) { const int b = u >> 11, rem = u & 2047; c_unit(X, b, rem >> 10, rem & 1023, I.lane); }
    }
}

__device__ __forceinline__ void phase_combine(ArgsP a) {
    const Ids I = make_ids(); unsigned char* ws = ws_base(a);
    const float* lse = (const float*)(ws + WS_LSE); half_t* mix = (half_t*)(ws + WS_MIX);
    for (int idx0 = I.gtid; idx0 < M * 48; idx0 += 4 * I.NT) {
        float l0[4], l1[4], l2[4]; half8 v[4]; bool ok[4];
#pragma unroll
        for (int u = 0; u < 4; ++u) {
            const int idx = idx0 + u * I.NT; ok[u] = idx < M * 48;
            const int ix = ok[u] ? idx : idx0;
            const int c8 = ix & 7, h6 = (ix >> 3) % 6, mrow = ix / 48, hh = h6 & 1;
            l0[u] = lse[(size_t)mrow * 6 + hh]; l1[u] = lse[(size_t)mrow * 6 + 2 + hh]; l2[u] = lse[(size_t)mrow * 6 + 4 + hh];
            v[u] = *(const half8*)(mix + (size_t)mrow * D + (4 + h6) * 64 + c8 * 8);
        }
#pragma unroll
        for (int u = 0; u < 4; ++u) {
            const int idx = idx0 + u * I.NT;
            if (!ok[u]) continue;
            const int c8 = idx & 7, h6 = (idx >> 3) % 6, mrow = idx / 48, gsel = h6 >> 1;
            const float mx = fmaxf(l0[u], fmaxf(l1[u], l2[u]));
            const float e0 = __builtin_amdgcn_exp2f(l0[u] - mx), e1 = __builtin_amdgcn_exp2f(l1[u] - mx), e2 = __builtin_amdgcn_exp2f(l2[u] - mx);
            const float al = (gsel == 0 ? e0 : (gsel == 1 ? e1 : e2)) / (e0 + e1 + e2);
            half8 w = v[u];
#pragma unroll
            for (int j = 0; j < 8; ++j) w[j] = (half_t)((float)w[j] * al);
            *(half8*)(mix + (size_t)mrow * D + (4 + h6) * 64 + c8 * 8) = w;
        }
    }
}

__device__ __forceinline__ void phase_outproj(ArgsP a, int layer, unsigned char* lds) {
    unsigned char* ws = ws_base(a);
    pg8::Gemm g{(const half_t*)(ws + WS_MIX), (const half_t*)(ws + WS_WT_OUT) + (size_t)layer * D * D, M, D, D, D};
    pg8::StaticOrder So; So.init(M, D, (int)gridDim.x, opaque_bid());
    pg8::EpiF16 E{(half_t*)(ws + WS_HX), D};
    pg8::gemm_phase<pg8::EpiF16>((PG8_LAS unsigned char*)lds, g, So, E);
}

__device__ __forceinline__ void phase_r1(ArgsP a, int layer) {
    const Ids I = make_ids(); unsigned char* ws = ws_base(a);
    const float* adaL = (const float*)(ws + WS_ADA) + (size_t)layer * 2 * 6144; const float* nw = a->norm_w + (size_t)layer * 4 * D; half_t* hx = (half_t*)(ws + WS_HX);
    half_t* x16 = (half_t*)(ws + WS_X16);
    if (layer == 0) rowwise_phase<true, true, 0, 1>(a->x, x16, nullptr, hx, nw + 1 * D, adaL + 2048, nw + 2 * D, adaL + 4096, adaL + 3072, hx, I.gw, I.NW, I.lane);
    else rowwise_phase<true, true, 1, 1>(nullptr, x16, nullptr, hx, nw + 1 * D, adaL + 2048, nw + 2 * D, adaL + 4096, adaL + 3072, hx, I.gw, I.NW, I.lane);
}

__device__ __forceinline__ void phase_gateup(ArgsP a, int layer, unsigned char* lds) {
    unsigned char* ws = ws_base(a);
    pg8::Gemm g{(const half_t*)(ws + WS_HX), (const half_t*)(ws + WS_WT_GU), M, NGU, D, D};
    pg8::StaticOrder So; So.init(M, NGU, (int)gridDim.x, opaque_bid());
    pg8::EpiAct E{(half_t*)(ws + WS_ACT), a->conv_w + (size_t)layer * 3 * DFF, a->conv_b + (size_t)layer * DFF, (float*)(ws + WS_GB), (float*)(ws + WS_UB)};
    pg8::gemm_phase<pg8::EpiAct>((PG8_LAS unsigned char*)lds, g, So, E);
}

__device__ __forceinline__ void phase_act(ArgsP a, int layer) {
    const Ids I = make_ids(); unsigned char* ws = ws_base(a);
    half_t* act = (half_t*)(ws + WS_ACT); const float* gb = (const float*)(ws + WS_GB); const float* ub = (const float*)(ws + WS_UB);
    const float* cw = a->conv_w + (size_t)layer * 3 * DFF; const float* cb = a->conv_b + (size_t)layer * DFF;
    for (int idx0 = I.gtid; idx0 < 128 * 2 * DFF; idx0 += 4 * I.NT) {
        float g0[4], uu[4], gm1[4], gm2[4], gr0[4], c0[4], c1[4], c2[4], cbv[4]; bool ok[4];
#pragma unroll
        for (int u = 0; u < 4; ++u) {
            const int idx = idx0 + u * I.NT; ok[u] = idx < 128 * 2 * DFF;
            const int ix = ok[u] ? idx : idx0;
            const int pm = ix / (2 * DFF), rem = ix % (2 * DFF), row = rem / DFF, j = rem % DFF;
            g0[u] = gb[((size_t)pm * 4 + row) * DFF + j]; uu[u] = ub[((size_t)pm * 2 + row) * DFF + j];
            gm1[u] = 0.f; gm2[u] = 0.f;
            if ((pm & 63) != 0) { gm1[u] = gb[((size_t)(pm - 1) * 4 + 3) * DFF + j]; gm2[u] = gb[((size_t)(pm - 1) * 4 + 2) * DFF + j]; }
            gr0[u] = gb[((size_t)pm * 4 + 0) * DFF + j];
            c0[u] = cw[j]; c1[u] = cw[DFF + j]; c2[u] = cw[2 * DFF + j]; cbv[u] = cb[j];
        }
#pragma unroll
        for (int u = 0; u < 4; ++u) {
            const int idx = idx0 + u * I.NT;
            if (!ok[u]) continue;
            const int pm = idx / (2 * DFF), rem = idx % (2 * DFF), row = rem / DFF, j = rem % DFF;
            const float g1 = row == 0 ? gm1[u] : gr0[u], g2 = row == 0 ? gm2[u] : gm1[u];
            const float v = c0[u] * g2 + c1[u] * g1 + c2[u] * g0[u] + cbv[u];
            act[((size_t)pm * 256 + row) * DFF + j] = (half_t)(gelu_tanh(v) * uu[u]);
        }
    }
}

__device__ __forceinline__ void phase_down(ArgsP a, int layer, unsigned char* lds) {
    unsigned char* ws = ws_base(a);
    pg8::Gemm g{(const half_t*)(ws + WS_ACT), (const half_t*)(ws + WS_WT_DN) + (size_t)layer * D * DFF, M, D, DFF, DFF};
    pg8::StaticOrder So; So.init(M, D, (int)gridDim.x, opaque_bid());
    pg8::EpiF16 E{(half_t*)(ws + WS_HX), D};
    pg8::gemm_phase<pg8::EpiF16>((PG8_LAS unsigned char*)lds, g, So, E);
}

__device__ __forceinline__ void phase_r2(ArgsP a, int layer) {
    const Ids I = make_ids(); unsigned char* ws = ws_base(a);
    const float* ada = (const float*)(ws + WS_ADA); const float* adaL = ada + (size_t)layer * 2 * 6144; const float* nw = a->norm_w + (size_t)layer * 4 * D; half_t* hx = (half_t*)(ws + WS_HX);
    if (layer + 1 < DEPTH) {
        const float* adaN = ada + (size_t)(layer + 1) * 2 * 6144;
        rowwise_phase<true, true, 1, 1>(nullptr, (half_t*)(ws + WS_X16), nullptr, hx, nw + 3 * D, adaL + 5120, a->norm_w + (size_t)(layer + 1) * 4 * D, adaN + 1024, adaN + 0, hx, I.gw, I.NW, I.lane);
    } else {
        rowwise_phase<true, false, 1, 2>(nullptr, (half_t*)(ws + WS_X16), a->out, hx, nw + 3 * D, adaL + 5120, nullptr, nullptr, nullptr, nullptr, I.gw, I.NW, I.lane);
    }
}

#define LAS __attribute__((address_space(3)))
#define XB_TMO      128
#define XB_XCNT(j)  (256  + 64 * (j))
#define XB_XSUB(j)  (1280 + 64 * (j))
#define XB_XGEN(j)  (2304 + 64 * (j))
#define XB_TOP      3328
#define XB_TOPGEN   3392
#define XCD_BAR_WORDS 3456
#define XB_SPIN_CAP (1u << 22)
__device__ __forceinline__ unsigned xb_ld(unsigned* p)              { return __hip_atomic_load(p, __ATOMIC_RELAXED, __HIP_MEMORY_SCOPE_AGENT); }
__device__ __forceinline__ unsigned xb_add(unsigned* p, unsigned v) { return __hip_atomic_fetch_add(p, v, __ATOMIC_RELAXED, __HIP_MEMORY_SCOPE_AGENT); }
__device__ __forceinline__ unsigned xb_xcc_id() { return (unsigned)__builtin_amdgcn_s_getreg((3 << 11) | 20) & 0xFu; }
#define XB_SPIN(cond, bar) do { unsigned _sp = 0; while (cond) { __builtin_amdgcn_s_sleep(1); \
    if ((++_sp & 255u) == 0u) { if (xb_ld(&(bar)[XB_TMO])) break; if (_sp > XB_SPIN_CAP) { atomicAdd(&(bar)[XB_TMO], 1u); break; } } } } while (0)
__device__ __forceinline__ void xcd_barrier_complete(unsigned* bar, unsigned x, unsigned& nloc, unsigned& nx) {
    const unsigned G = gridDim.x * gridDim.y * gridDim.z;
    unsigned sum, cnt, mine, sp = 0u;
    for (;;) {
        sum = 0u; cnt = 0u; mine = 0u;
#pragma unroll
        for (unsigned j = 0; j < 16; ++j) { const unsigned c = xb_ld(&bar[XB_XCNT(j)]); sum += c; cnt += (c > 0u) ? 1u : 0u; mine = (j == x) ? c : mine; }
        if (sum == G) break;
        __builtin_amdgcn_s_sleep(1);
        if ((++sp & 255u) == 0u) { if (xb_ld(&bar[XB_TMO])) break; if (sp > XB_SPIN_CAP) { atomicAdd(&bar[XB_TMO], 1u); break; } }
    }
    nloc = mine > 0u ? mine : 1u; nx = cnt > 0u ? cnt : 1u;
}
__device__ __forceinline__ void xcd_barrier(unsigned* bar, volatile LAS unsigned* st) {
    asm volatile("s_waitcnt vmcnt(0)" ::: "memory");
    __syncthreads();
    if (threadIdx.x == 0) {
        const unsigned x = xb_xcc_id();
        __builtin_amdgcn_s_waitcnt(0);
        unsigned nloc = st[0], nx = st[1];
        if (nloc == 0u) { xcd_barrier_complete(bar, x, nloc, nx); st[0] = nloc; st[1] = nx; }
        const unsigned old = xb_add(&bar[XB_XSUB(x)], 1u);
        const unsigned gen = old / nloc;
        if (old + 1u == (gen + 1u) * nloc) {
            __builtin_amdgcn_fence(__ATOMIC_RELEASE, "agent");
            asm volatile("s_waitcnt vmcnt(0)" ::: "memory");
            const unsigned og = xb_add(&bar[XB_TOP], 1u);
            const unsigned tg = og / nx;
            if (og + 1u == (tg + 1u) * nx) xb_add(&bar[XB_TOPGEN], 1u);
            else XB_SPIN(xb_ld(&bar[XB_TOPGEN]) == tg, bar);
            __builtin_amdgcn_fence(__ATOMIC_ACQUIRE, "agent");
            xb_add(&bar[XB_XGEN(x)], 1u);
            asm volatile("s_waitcnt vmcnt(0)" ::: "memory");
        } else {
            XB_SPIN(xb_ld(&bar[XB_XGEN(x)]) == gen, bar);
            __builtin_amdgcn_fence(__ATOMIC_ACQUIRE, "agent");
            asm volatile("s_waitcnt vmcnt(0)" ::: "memory");
        }
    }
    __syncthreads();
}

__global__ void __launch_bounds__(NTHREADS, 2) trunk_fwd(Args a) {
    extern __shared__ __attribute__((aligned(16))) unsigned char lds[];
    cg::grid_group grid = cg::this_grid();
    volatile LAS unsigned* bst = (volatile LAS unsigned*)((LAS unsigned char*)lds + (LDS_BYTES - 64));
    if (threadIdx.x < 2) bst[threadIdx.x] = 0u;
    if (blockIdx.x == 0) { unsigned* bw = (unsigned*)(a.ws + WS_BAR); for (int i = threadIdx.x; i < XCD_BAR_WORDS; i += NTHREADS) bw[i] = 0u; }
    if (PH & 1) phase_p0a(largs(), lds);
    if (REP & 1) { phase_p0a(largs(), lds); }
    grid.sync();
    if (threadIdx.x == 0) (void)xb_add((unsigned*)(largs()->ws + WS_BAR) + XB_XCNT(xb_xcc_id()), 1u);
#define GSYNC() xcd_barrier((unsigned*)(largs()->ws + WS_BAR), bst)
    if (PH & 2) phase_p0b(largs());
    GSYNC();
    for (int layer = 0; layer < DEPTH; ++layer) {
        if (PH & 4) phase_inproj(largs(), layer, lds);
        GSYNC();
        if (REP & 4) { phase_inproj(largs(), layer, lds); GSYNC(); }
        if (PH & 8) phase_compress(largs(), layer, lds);
        GSYNC();
        if (REP & 8) { phase_compress(largs(), layer, lds); GSYNC(); }
        if (PH & 16) phase_attn(largs(), layer, lds);
        GSYNC();
        if (REP & 16) { phase_attn(largs(), layer, lds); GSYNC(); }
        if (PH & 32) phase_combine(largs());
        GSYNC();
        if (PH & 64) phase_outproj(largs(), layer, lds);
        GSYNC();
        if (REP & 64) { phase_outproj(largs(), layer, lds); GSYNC(); }
        if (PH & 128) phase_r1(largs(), layer);
        GSYNC();
        if (PH & 256) phase_gateup(largs(), layer, lds);
        GSYNC();
        if (REP & 256) { phase_gateup(largs(), layer, lds); GSYNC(); }
        if (PH & 512) phase_act(largs(), layer);
        GSYNC();
        if (PH & 1024) phase_down(largs(), layer, lds);
        GSYNC();
        if (REP & 1024) { phase_down(largs(), layer, lds); GSYNC(); }
        if (PH & 2048) phase_r2(largs(), layer);
        if (layer + 1 < DEPTH) GSYNC();
    }
}

extern "C" void kernel_launch(void* const* d_in, const int* in_sizes, int n_in, void* d_out, int out_size, void* d_ws, size_t ws_size, hipStream_t stream) {
    static int grid = 0;
    if (grid == 0) {
        int dev = 0, cus = 0, per_cu = 0;
        if (n_in != 18 || ws_size < WS_END) { fprintf(stderr, "kernel_launch: unexpected inputs (n_in %d, ws %zu)\n", n_in, ws_size); grid = -1; return; }
        hipGetDevice(&dev);
        hipDeviceGetAttribute(&cus, hipDeviceAttributeMultiprocessorCount, dev);
        hipFuncSetAttribute((const void*)trunk_fwd, hipFuncAttributeMaxDynamicSharedMemorySize, LDS_BYTES);
        hipOccupancyMaxActiveBlocksPerMultiprocessor(&per_cu, (const void*)trunk_fwd, NTHREADS, LDS_BYTES);
        if (per_cu < 1) per_cu = 1;
        grid = cus * per_cu;
        (void)hipGetLastError();
    }
    if (grid < 0) return;
    Args a{};
    a.x = (const float*)d_in[0]; a.c = (const float*)d_in[1]; a.positions = (const int*)d_in[2]; a.w_in = (const float*)d_in[3]; a.w_out = (const float*)d_in[4];
    a.w_ada = (const float*)d_in[5]; a.b_ada = (const float*)d_in[6]; a.norm_w = (const float*)d_in[7]; a.cmp_w_k = (const float*)d_in[8]; a.cmp_w_v = (const float*)d_in[9];
    a.cmp_pe_k = (const float*)d_in[10]; a.cmp_pe_v = (const float*)d_in[11]; a.sinks = (const float*)d_in[12]; a.w_gate = (const float*)d_in[13]; a.w_up = (const float*)d_in[14];
    a.conv_w = (const float*)d_in[15]; a.conv_b = (const float*)d_in[16]; a.w_down = (const float*)d_in[17];
    a.out = (float*)d_out; a.ws = (unsigned char*)d_ws;
    for (int i = 0; i < 32; ++i) a.inv_freq[i] = (float)pow(10000.0, -(double)i / 32.0);
    void* args[] = {&a};
    hipError_t e = hipLaunchCooperativeKernel((const void*)trunk_fwd, dim3(grid), dim3(NTHREADS), args, LDS_BYTES, stream);
    if (e != hipSuccess) fprintf(stderr, "cooperative launch failed: %s (grid %d)\n", hipGetErrorString(e), grid);
}
```
